# Optimizing an MI355X kernel written in HIP

```python
import jax, jax.numpy as jnp
from jax import lax
import numpy as np

D_MODEL = 1024
BATCH = 8
SEQ = 2048
DEPTH = 4

CHUNK = 64
N_MIXERS = 3
A_HEADS = 16
A_HEAD_DIM = D_MODEL // A_HEADS
A_Q_BLOCK = 128
B_HEADS = 8
B_HEAD_DIM = D_MODEL // B_HEADS
B_CONV = 4
C_WIDTH = 2 * D_MODEL
C_GROUPS = 8
C_SPAN = 128
D_FF = -(-8 * D_MODEL // (3 * 256)) * 256
EPS = 1e-6
N_A = (DEPTH + 2) // 3
N_B = (DEPTH + 1) // 3
N_C = DEPTH // 3

kernel_name = 'fox_mlstm_gmlp_interleaved_trunk'


def rmsnorm(x, g):
    xf = x.astype(jnp.float32)
    y = xf * lax.rsqrt(jnp.mean(xf * xf, axis=-1, keepdims=True) + EPS)
    return (y * g.astype(jnp.float32)).astype(x.dtype)


def forgetting_attention(h, w_in, b_f, w_out):
    B, S, D = h.shape
    proj = h @ w_in
    q, k, v, f = jnp.split(proj, [D, 2 * D, 3 * D], axis=-1)
    to_heads = lambda t: t.reshape(B, S, A_HEADS, A_HEAD_DIM).transpose(0, 2, 1, 3)
    q, k, v = to_heads(q), to_heads(k), to_heads(v)
    logf = jax.nn.log_sigmoid((f + b_f).astype(jnp.float32))
    c = jnp.cumsum(logf, axis=1).transpose(0, 2, 1)
    scale = A_HEAD_DIM ** -0.5
    outs = []
    for j in range(S // A_Q_BLOCK):
        q0, q1 = j * A_Q_BLOCK, (j + 1) * A_Q_BLOCK
        s = jnp.einsum('bhqd,bhkd->bhqk', q[:, :, q0:q1], k[:, :, :q1]).astype(jnp.float32) * scale
        s = s + c[:, :, q0:q1, None] - c[:, :, None, :q1]
        mask = (q0 + jnp.arange(A_Q_BLOCK))[:, None] >= jnp.arange(q1)[None, :]
        p = jax.nn.softmax(jnp.where(mask, s, -jnp.inf), axis=-1)
        outs.append(jnp.einsum('bhqk,bhkd->bhqd', p.astype(v.dtype), v[:, :, :q1]))
    o = jnp.concatenate(outs, axis=2).transpose(0, 2, 1, 3).reshape(B, S, D)
    return o @ w_out


def causal_dwconv(x, w, b):
    K = w.shape[0]
    y = lax.conv_general_dilated(x, w[:, None, :], window_strides=(1,), padding=[(K - 1, 0)],
                                 dimension_numbers=('NWC', 'WIO', 'NWC'),
                                 feature_group_count=x.shape[-1])
    return y + b


def mlstm_mixer(h, w_in, conv_w, conv_b, b_i, b_f, norm_g, w_out):
    B, S, D = h.shape
    H, d, L = B_HEADS, B_HEAD_DIM, CHUNK
    NC = S // L
    proj = h @ w_in
    qk, v, o, ig, fg = jnp.split(proj, [2 * D, 3 * D, 4 * D, 4 * D + H], axis=-1)
    qk = jax.nn.silu(causal_dwconv(qk, conv_w, conv_b))
    q, k = jnp.split(qk, 2, axis=-1)
    to_chunks = lambda t: t.reshape(B, NC, L, H, d).transpose(1, 0, 3, 2, 4).astype(jnp.float32)
    q, k, v = to_chunks(q), to_chunks(k) * (d ** -0.5), to_chunks(v)
    gate_chunks = lambda t: t.astype(jnp.float32).reshape(B, NC, L, H).transpose(1, 0, 3, 2)
    ig = gate_chunks(ig + b_i)
    lf = gate_chunks(jax.nn.log_sigmoid((fg + b_f).astype(jnp.float32)))
    tri = jnp.arange(L)[:, None] >= jnp.arange(L)[None, :]

    def step(carry, inp):
        C, n, m = carry
        qc, kc, vc, igc, lfc = inp
        bcum = jnp.cumsum(lfc, axis=-1)
        log_D = jnp.where(tri, bcum[..., :, None] - bcum[..., None, :] + igc[..., None, :], -jnp.inf)
        m_inter = bcum + m[..., None]
        m_t = jnp.maximum(m_inter, jnp.max(log_D, axis=-1))
        Dm = jnp.exp(log_D - m_t[..., None])
        a = jnp.exp(m_inter - m_t)
        sqk = jnp.einsum('bhtd,bhsd->bhts', qc, kc) * Dm
        num = a[..., None] * jnp.einsum('bhtd,bhde->bhte', qc, C) + jnp.einsum('bhts,bhse->bhte', sqk, vc)
        den = a * jnp.einsum('bhtd,bhd->bht', qc, n) + jnp.sum(sqk, axis=-1)
        hc = num / jnp.maximum(jnp.abs(den), jnp.exp(-m_t))[..., None]
        bL = bcum[..., -1]
        g = bL[..., None] - bcum + igc
        m_new = jnp.maximum(bL + m, jnp.max(g, axis=-1))
        w = jnp.exp(g - m_new[..., None])
        decay = jnp.exp(bL + m - m_new)
        C = decay[..., None, None] * C + jnp.einsum('bhsd,bhse->bhde', kc * w[..., None], vc)
        n = decay[..., None] * n + jnp.einsum('bhs,bhsd->bhd', w, kc)
        return (C, n, m_new), hc

    init = (jnp.zeros((B, H, d, d), jnp.float32), jnp.zeros((B, H, d), jnp.float32),
            jnp.zeros((B, H), jnp.float32))
    _, hs = lax.scan(step, init, (q, k, v, ig, lf))
    hs = hs.transpose(1, 0, 3, 2, 4).reshape(B, S, H, d)
    hs = hs * lax.rsqrt(jnp.mean(hs * hs, axis=-1, keepdims=True) + EPS)
    hs = hs.reshape(B, S, D) * norm_g.astype(jnp.float32)
    out = hs.astype(h.dtype) * jax.nn.sigmoid(o)
    return out @ w_out


def gmlp_mixer(h, w_in, ln_g, ln_b, w_s, b_s, w_out):
    B, S, D = h.shape
    z = jax.nn.gelu(h @ w_in, approximate=False)
    u, v = jnp.split(z, 2, axis=-1)
    vf = v.astype(jnp.float32)
    mu = jnp.mean(vf, axis=-1, keepdims=True)
    var = jnp.mean(jnp.square(vf - mu), axis=-1, keepdims=True)
    v = ((vf - mu) * lax.rsqrt(var + EPS) * ln_g + ln_b).astype(h.dtype)
    v = v.reshape(B, S // C_SPAN, C_SPAN, C_GROUPS, C_WIDTH // C_GROUPS)
    pos = jnp.arange(C_SPAN)
    mask = (pos[:, None] // CHUNK) >= (pos[None, :] // CHUNK)
    ws = w_s * mask
    s = jnp.einsum('gts,bnsgc->bntgc', ws, v) + b_s.T[None, None, :, :, None]
    out = u * s.reshape(B, S, C_WIDTH)
    return out @ w_out


def swiglu(h, w_gu, w_down):
    g, u = jnp.split(h @ w_gu, 2, axis=-1)
    return (jax.nn.silu(g) * u) @ w_down


def setup_inputs(seed: int = 0) -> dict:
    key = jax.random.key(seed)
    ks = iter(jax.random.split(key, 32))
    nrm = lambda shape, scale: jax.random.normal(next(ks), shape, jnp.float32) * scale
    D = D_MODEL
    return {
        'x': nrm((BATCH, SEQ, D), 1.0),
        'norm1_g': 1.0 + nrm((DEPTH, D), 0.02),
        'norm2_g': 1.0 + nrm((DEPTH, D), 0.02),
        'final_g': 1.0 + nrm((D,), 0.02),
        'a_w_in': nrm((N_A, D, 3 * D + A_HEADS), D ** -0.5),
        'a_b_f': jnp.linspace(1.0, 5.0, A_HEADS)[None, :] + nrm((N_A, A_HEADS), 0.1),
        'a_w_out': nrm((N_A, D, D), D ** -0.5),
        'b_w_in': nrm((N_B, D, 4 * D + 2 * B_HEADS), D ** -0.5),
        'b_conv_w': nrm((N_B, B_CONV, 2 * D), B_CONV ** -0.5),
        'b_conv_b': nrm((N_B, 2 * D), 0.01),
        'b_b_i': nrm((N_B, B_HEADS), 0.1),
        'b_b_f': jnp.linspace(3.0, 6.0, B_HEADS)[None, :] + nrm((N_B, B_HEADS), 0.1),
        'b_norm_g': 1.0 + nrm((N_B, D), 0.02),
        'b_w_out': nrm((N_B, D, D), D ** -0.5),
        'c_w_in': nrm((N_C, D, 2 * C_WIDTH), D ** -0.5),
        'c_ln_g': 1.0 + nrm((N_C, C_WIDTH), 0.02),
        'c_ln_b': nrm((N_C, C_WIDTH), 0.01),
        'c_w_s': nrm((N_C, C_GROUPS, C_SPAN, C_SPAN), C_SPAN ** -0.5),
        'c_b_s': 1.0 + nrm((N_C, C_GROUPS, C_SPAN), 0.02),
        'c_w_out': nrm((N_C, C_WIDTH, D), C_WIDTH ** -0.5),
        'ffn_w_gu': nrm((DEPTH, D, 2 * D_FF), D ** -0.5),
        'ffn_w_down': nrm((DEPTH, D_FF, D), D_FF ** -0.5),
    }


def reference(x, norm1_g, norm2_g, final_g, a_w_in, a_b_f, a_w_out, b_w_in, b_conv_w, b_conv_b,
              b_b_i, b_b_f, b_norm_g, b_w_out, c_w_in, c_ln_g, c_ln_b, c_w_s, c_b_s, c_w_out,
              ffn_w_gu, ffn_w_down):
    for i in range(DEPTH):
        kind, j = i % N_MIXERS, i // N_MIXERS
        hn = rmsnorm(x, norm1_g[i])
        if kind == 0:
            y = forgetting_attention(hn, a_w_in[j], a_b_f[j], a_w_out[j])
        elif kind == 1:
            y = mlstm_mixer(hn, b_w_in[j], b_conv_w[j], b_conv_b[j], b_b_i[j], b_b_f[j],
                            b_norm_g[j], b_w_out[j])
        else:
            y = gmlp_mixer(hn, c_w_in[j], c_ln_g[j], c_ln_b[j], c_w_s[j], c_b_s[j], c_w_out[j])
        x = x + y
        x = x + swiglu(rmsnorm(x, norm2_g[i]), ffn_w_gu[i], ffn_w_down[i])
    return rmsnorm(x, final_g)
```

```cpp
#include <hip/hip_cooperative_groups.h>
#include <hip/hip_runtime.h>
__device__ __forceinline__ int mk_ltid(int wv) { unsigned z = 0u; asm volatile("" : "+s"(z)); int t = (wv << 6) | (int)__builtin_amdgcn_mbcnt_hi(~0u, __builtin_amdgcn_mbcnt_lo(~0u, z)); asm volatile("" : "+v"(t)); return t; }
#include <hip/hip_runtime.h>
#include <cstdio>
#include <cstdint>
namespace pg8 {
#define PG8_LAS __attribute__((address_space(3)))
typedef unsigned short bf16_t;
typedef short bf16x8 __attribute__((ext_vector_type(8)));
typedef float f32x4 __attribute__((ext_vector_type(4)));
typedef unsigned u32x4 __attribute__((ext_vector_type(4)));
constexpr int BM = 256, BK = 64, HALF = 128, HTB = HALF * BK * 2  , STAGE_BYTES = 8 * HTB, NXCD = 8, WGM = 2;

__host__ __device__ __forceinline__ int lds_byte(int r, int c) { const int st = (r >> 4) * 2 + (c >> 5), rr = r & 15, cc = c & 31, ob = rr * 64 + cc * 2; return st * 1024 + (ob ^ (((ob >> 9) & 1) << 5)); }
__host__ __device__ __forceinline__ void stage_rc(int b, int& R, int& C) { const int st = b / 1024, sb = b % 1024, swz = sb ^ (((sb >> 9) & 1) << 5); R = (st >> 1) * 16 + swz / 64; C = (st & 1) * 32 + (swz % 64) / 2; }
__host__ __device__ __forceinline__ int perm32(int rho) { const int n = rho >> 4, i = rho & 15; return 8 * (i >> 2) + 4 * n + (i & 3); }

struct Unit { int pm, pn, ord; };
struct Gemm { const bf16_t* A; const bf16_t* Bt; int M, N, K; };

struct StaticOrder {
    int nM, nN, nwg, G, c;
    __host__ __device__ void init(int M, int N, int G_, int c_) { nM = M / BM; nN = N / BM; nwg = nM * nN; G = G_; c = c_; }
    __host__ __device__ bool next(int i, Unit& u) const {
        const long L = (long)i * G + c; if (L >= nwg) return false;
        int wgid = (int)L; { const int q = nwg / NXCD, r = nwg % NXCD, xcd = wgid % NXCD, off = wgid / NXCD; wgid = (xcd < r ? xcd * (q + 1) : r * (q + 1) + (xcd - r) * q) + off; }
#if defined(PG8_NMAJOR) && PG8_NMAJOR
        u.pm = wgid % nM; u.pn = wgid / nM; u.ord = i; return true;
#else
        const int nig = WGM * nN, gid = wgid / nig, fm = gid * WGM, gsz = (nM - fm) < WGM ? (nM - fm) : WGM;
        u.pm = fm + ((wgid % nig) % gsz); u.pn = (wgid % nig) / gsz; u.ord = i; return true;
#endif
    }
    __device__ __forceinline__ void a_ready(const Unit&) const {}
    __device__ __forceinline__ void done(const Unit&) const {}
};

__device__ __forceinline__ unsigned cvt_pk_bf16(float lo, float hi) { unsigned r; asm volatile("v_cvt_pk_bf16_f32 %0, %1, %2" : "=v"(r) : "v"(lo), "v"(hi)); return r; }
typedef float f32x2 __attribute__((ext_vector_type(2)));
__device__ __forceinline__ f32x2 gelu_pk(f32x2 v) {
    const f32x2 av = __builtin_elementwise_abs(v), d = av * 0.2316418882f + 1.0f;
    f32x2 t; t.x = __builtin_amdgcn_rcpf(d.x); t.y = __builtin_amdgcn_rcpf(d.y);
    f32x2 q = t * 0.5307027145f + (-0.7265760135f); q = q * t + 0.7107068705f; q = q * t + (-0.142248368f); q = q * t + 0.127414796f; q = q * t;
    const f32x2 s = (v * v) * (-0.72134752044f);
    f32x2 e; e.x = __builtin_amdgcn_exp2f(s.x); e.y = __builtin_amdgcn_exp2f(s.y);
    const f32x2 m = v * (q * e), r = v - m;
    f32x2 o; o.x = v.x < 0.f ? m.x : r.x; o.y = v.y < 0.f ? m.y : r.y; return o;
}

__device__ __forceinline__ float row_rstd(const float* ssq, int row, int fq) {
    const f32x4 v = *(const f32x4*)(ssq + (size_t)row * 16 + 4 * fq);
    float s = (v[0] + v[1]) + (v[2] + v[3]); s += __shfl_xor(s, 16); s += __shfl_xor(s, 32);
    return 1.0f / sqrtf(s * (1.0f / 1024.0f) + 1e-6f);
}
__device__ __forceinline__ unsigned pkbf(float lo, float hi) { typedef float f2_t __attribute__((ext_vector_type(2))); typedef __bf16 b2_t __attribute__((ext_vector_type(2))); f2_t v = {lo, hi}; b2_t b = __builtin_convertvector(v, b2_t); return __builtin_bit_cast(unsigned, b); }

#ifndef PG8_ST_MODE
#define PG8_ST_MODE 1
#endif
__device__ __forceinline__ void st16(void* p, u32x4 v) {
    asm volatile("global_store_dwordx4 %0, %1, off sc1\n\ts_nop 1" :: "v"(p), "v"(v) : "memory");
}
__device__ __forceinline__ void st16e(void* p, u32x4 v) {
#if PG8_ST_MODE == 0
    *(u32x4*)p = v;
#elif PG8_ST_MODE == 1
    asm volatile("global_store_dwordx4 %0, %1, off sc1\n\ts_nop 1" :: "v"(p), "v"(v) : "memory");
#elif PG8_ST_MODE == 2
    asm volatile("global_store_dwordx4 %0, %1, off sc1 nt\n\ts_nop 1" :: "v"(p), "v"(v) : "memory");
#else
    asm volatile("global_store_dwordx4 %0, %1, off nt\n\ts_nop 1" :: "v"(p), "v"(v) : "memory");
#endif
}
struct EpiScaleBf16 {
    static constexpr bool PERM = true, AFTER_DRAIN = false;
    bf16_t* O; int ldc; const PG8_LAS float* rs; int split_cols; size_t split_stride; float scale0;
    __device__ __forceinline__ void operator()(const f32x4 (&acc)[2][2][4][2], const Unit& u, int wr, int wc, int fr, int fq) const {
        const int row0 = u.pm * BM + wr * 64 + fr; int colt = u.pn * BM; bf16_t* base = O;
        float sc = 1.f; if (split_cols) { const int t = colt / split_cols; base += (size_t)t * split_stride; colt -= t * split_cols; if (t == 0) sc = scale0; }
        const int col0 = colt + wc * 32 + 8 * fq;
#pragma unroll
        for (int ai = 0; ai < 2; ++ai)
#pragma unroll
            for (int m = 0; m < 4; ++m) { const int row = row0 + ai * HALF + m * 16; const float r = rs[u.ord * 256 + wr * 64 + fr + ai * HALF + m * 16] * sc; bf16_t* rowp = base + (size_t)row * ldc + col0;
#pragma unroll
                for (int bj = 0; bj < 2; ++bj) { const f32x4 v0 = acc[ai][bj][m][0] * r, v1 = acc[ai][bj][m][1] * r;
                    u32x4 w; w.x = pkbf(v0[0], v0[1]); w.y = pkbf(v0[2], v0[3]); w.z = pkbf(v1[0], v1[1]); w.w = pkbf(v1[2], v1[3]);
                    st16e(rowp + bj * HALF, w); } }
    }
};
__device__ __forceinline__ float silu_f(float x) { return x * __builtin_amdgcn_rcpf(1.0f + __builtin_amdgcn_exp2f(-1.4426950408889634f * x)); }
struct EpiSwiGLU {
    static constexpr bool PERM = true, AFTER_DRAIN = false;
    bf16_t* O; const PG8_LAS float* rs;
    __device__ __forceinline__ void operator()(const f32x4 (&acc)[2][2][4][2], const Unit& u, int wr, int wc, int fr, int fq) const {
        const int row0 = u.pm * BM + wr * 64 + fr, col0 = u.pn * HALF + wc * 32 + 8 * fq;
#pragma unroll
        for (int ai = 0; ai < 2; ++ai)
#pragma unroll
            for (int m = 0; m < 4; ++m) { const int row = row0 + ai * HALF + m * 16; const float r = rs[u.ord * 256 + wr * 64 + fr + ai * HALF + m * 16];
                const f32x4 g0 = acc[ai][0][m][0] * r, g1 = acc[ai][0][m][1] * r, u0 = acc[ai][1][m][0] * r, u1 = acc[ai][1][m][1] * r;
                float a[8];
#pragma unroll
                for (int j = 0; j < 4; ++j) { a[j] = silu_f(g0[j]) * u0[j]; a[4 + j] = silu_f(g1[j]) * u1[j]; }
                u32x4 w; w.x = pkbf(a[0], a[1]); w.y = pkbf(a[2], a[3]); w.z = pkbf(a[4], a[5]); w.w = pkbf(a[6], a[7]);
                st16e(O + (size_t)row * 2816 + col0, w); }
    }
};
struct EpiGeluLn {
    static constexpr bool PERM = true, AFTER_DRAIN = false;
    bf16_t* O; const PG8_LAS float* rs; float* lnp;
    __device__ __forceinline__ void operator()(const f32x4 (&acc)[2][2][4][2], const Unit& u, int wr, int wc, int fr, int fq) const {
        const int row0 = u.pm * BM + wr * 64 + fr, col0 = u.pn * BM + wc * 32 + 8 * fq;
#pragma unroll
        for (int ai = 0; ai < 2; ++ai)
#pragma unroll
            for (int m = 0; m < 4; ++m) { const int row = row0 + ai * HALF + m * 16; const float r = rs[u.ord * 256 + wr * 64 + fr + ai * HALF + m * 16]; bf16_t* rowp = O + (size_t)row * 4096 + col0;
                float s1 = 0.f, s2 = 0.f;
#pragma unroll
                for (int bj = 0; bj < 2; ++bj) { const f32x4 v0 = acc[ai][bj][m][0] * r, v1 = acc[ai][bj][m][1] * r;
                    const f32x2 a = gelu_pk((f32x2){v0[0], v0[1]}), b = gelu_pk((f32x2){v0[2], v0[3]}), c = gelu_pk((f32x2){v1[0], v1[1]}), d = gelu_pk((f32x2){v1[2], v1[3]});
                    s1 += ((a.x + a.y) + (b.x + b.y)) + ((c.x + c.y) + (d.x + d.y));
                    s2 += ((a.x * a.x + a.y * a.y) + (b.x * b.x + b.y * b.y)) + ((c.x * c.x + c.y * c.y) + (d.x * d.x + d.y * d.y));
                    u32x4 w; w.x = pkbf(a.x, a.y); w.y = pkbf(b.x, b.y); w.z = pkbf(c.x, c.y); w.w = pkbf(d.x, d.y);
                    st16e(rowp + bj * HALF, w); }
                if (u.pn >= 8) { s1 += __shfl_xor(s1, 16); s1 += __shfl_xor(s1, 32); s2 += __shfl_xor(s2, 16); s2 += __shfl_xor(s2, 32);
                    if (fq == 0) *(f32x2*)(lnp + ((size_t)row * 32 + (u.pn - 8) * 4 + wc) * 2) = (f32x2){s1, s2}; } }
    }
};
struct EpiResidual {
    static constexpr bool PERM = true, AFTER_DRAIN = false;
    const float* X; float* Xo; bf16_t* XB; float* ssq;
    __device__ __forceinline__ void operator()(const f32x4 (&acc)[2][2][4][2], const Unit& u, int wr, int wc, int fr, int fq) const {
        const int row0 = u.pm * BM + wr * 64 + fr, col0 = u.pn * BM + wc * 32 + 8 * fq;
#pragma unroll
        for (int ai = 0; ai < 2; ++ai)
#pragma unroll
            for (int m = 0; m < 4; ++m) { const int row = row0 + ai * HALF + m * 16; const float* xp = X + (size_t)row * 1024 + col0; float* xq = Xo + (size_t)row * 1024 + col0; bf16_t* bp = XB + (size_t)row * 1024 + col0; float q = 0.f;
#pragma unroll
                for (int bj = 0; bj < 2; ++bj) { f32x4 x0 = *(const f32x4*)(xp + bj * HALF), x1 = *(const f32x4*)(xp + bj * HALF + 4);
                    x0 += acc[ai][bj][m][0]; x1 += acc[ai][bj][m][1];
                    *(f32x4*)(xq + bj * HALF) = x0; *(f32x4*)(xq + bj * HALF + 4) = x1;
                    q += ((x0[0] * x0[0] + x0[1] * x0[1]) + (x0[2] * x0[2] + x0[3] * x0[3])) + ((x1[0] * x1[0] + x1[1] * x1[1]) + (x1[2] * x1[2] + x1[3] * x1[3]));
                    u32x4 w; w.x = pkbf(x0[0], x0[1]); w.y = pkbf(x0[2], x0[3]); w.z = pkbf(x1[0], x1[1]); w.w = pkbf(x1[2], x1[3]);
                    *(u32x4*)(bp + bj * HALF) = w; }
                q += __shfl_xor(q, 16); q += __shfl_xor(q, 32);
                if (fq == 0) ssq[(size_t)row * 16 + u.pn * 4 + wc] = q; }
    }
};

struct EpiResidualLds {
    static constexpr bool PERM = true, AFTER_DRAIN = true;
    const float* X; float* Xo; bf16_t* XB; float* ssq;
    __device__ __forceinline__ void operator()(const f32x4 (&)[2][2][4][2], const Unit&, int, int, int, int) const {}
    __device__ __forceinline__ void fused(f32x4 (&acc)[2][2][4][2], const Unit& u, int wr, int wc, int fr, int fq, PG8_LAS unsigned char* lds, int wid, int lane) const {
#pragma unroll
        for (int ai = 0; ai < 2; ++ai) {
#pragma unroll
            for (int m = 0; m < 4; ++m) { const int rl = 64 * wr + 16 * m + fr;
#pragma unroll
                for (int bj = 0; bj < 2; ++bj)
#pragma unroll
                    for (int n = 0; n < 2; ++n) { const int ch = 32 * bj + 8 * wc + 2 * fq + n; *(PG8_LAS f32x4*)(lds + rl * 1024 + ((ch ^ (rl & 7)) << 4)) = acc[ai][bj][m][n]; } }
            asm volatile("s_waitcnt lgkmcnt(0)" ::: "memory"); __builtin_amdgcn_s_barrier(); asm volatile("" ::: "memory");
#pragma unroll 4
            for (int i = 0; i < 16; ++i) { const int rl = 16 * wid + i; const size_t off = (size_t)(u.pm * BM + 128 * ai + rl) * 1024 + u.pn * BM + 4 * lane;
                const f32x4 a = *(const PG8_LAS f32x4*)(lds + rl * 1024 + ((lane ^ (rl & 7)) << 4));
                f32x4 x = *(const f32x4*)(X + off); x += a; *(f32x4*)(Xo + off) = x;
                float q = (x[0] * x[0] + x[1] * x[1]) + (x[2] * x[2] + x[3] * x[3]);
                typedef unsigned u32x2_t __attribute__((ext_vector_type(2))); u32x2_t w; w.x = pkbf(x[0], x[1]); w.y = pkbf(x[2], x[3]); *(u32x2_t*)(XB + off) = w;
#pragma unroll
                for (int o = 1; o < 64; o <<= 1) q += __shfl_xor(q, o);
                if (lane == 0) *(f32x4*)(ssq + (size_t)(u.pm * BM + 128 * ai + rl) * 16 + u.pn * 4) = (f32x4){q, 0.f, 0.f, 0.f}; }
            asm volatile("s_waitcnt lgkmcnt(0)" ::: "memory"); __builtin_amdgcn_s_barrier(); asm volatile("" ::: "memory");
        }
    }
};

struct EpiResidualB {
    static constexpr bool PERM = true, AFTER_DRAIN = false;
    bf16_t* XB; bf16_t* XBo; float* ssq;
    __device__ __forceinline__ void operator()(const f32x4 (&acc)[2][2][4][2], const Unit& u, int wr, int wc, int fr, int fq) const {
        const int row0 = u.pm * BM + wr * 64 + fr, col0 = u.pn * BM + wc * 32 + 8 * fq;
#pragma unroll
        for (int ai = 0; ai < 2; ++ai)
#pragma unroll
            for (int m = 0; m < 4; ++m) { const int row = row0 + ai * HALF + m * 16; const bf16_t* bp = XB + (size_t)row * 1024 + col0; bf16_t* bo = XBo + (size_t)row * 1024 + col0; float q = 0.f;
#pragma unroll
                for (int bj = 0; bj < 2; ++bj) { const u32x4 xv = *(const u32x4*)(bp + bj * HALF); const f32x4 a0 = acc[ai][bj][m][0], a1 = acc[ai][bj][m][1];
                    u32x4 w; w.x = pkbf(__uint_as_float(xv.x << 16) + a0[0], __uint_as_float(xv.x & 0xffff0000u) + a0[1]); w.y = pkbf(__uint_as_float(xv.y << 16) + a0[2], __uint_as_float(xv.y & 0xffff0000u) + a0[3]);
                    w.z = pkbf(__uint_as_float(xv.z << 16) + a1[0], __uint_as_float(xv.z & 0xffff0000u) + a1[1]); w.w = pkbf(__uint_as_float(xv.w << 16) + a1[2], __uint_as_float(xv.w & 0xffff0000u) + a1[3]);
                    st16(bo + bj * HALF, w);
#pragma unroll
                    for (int k = 0; k < 4; ++k) { const float lo = __uint_as_float(w[k] << 16), hi = __uint_as_float(w[k] & 0xffff0000u); q += lo * lo + hi * hi; } }
                q += __shfl_xor(q, 16); q += __shfl_xor(q, 32);
                if (fq == 0) ssq[(size_t)row * 16 + u.pn * 4 + wc] = q; }
    }
};
struct NoPre { __device__ __forceinline__ void issue(int) {} __device__ __forceinline__ void finish(int) {} };
template <class Epi, class Sched, bool ALIGN_EPI = false, bool SP2 = false, class Pre = NoPre>
__device__ __forceinline__ void gemm_phase(PG8_LAS unsigned char* lds, const Gemm g, const Sched& S, const Epi& E, const int wv, Pre pre = Pre()) {
    const int tid = mk_ltid(wv), wid = __builtin_amdgcn_readfirstlane(tid >> 6), lane = tid & 63, wr = wid >> 2, wc = wid & 3, fr = lane & 15, fq = lane >> 4;
    const int K = g.K, nt = K / BK;
    unsigned voffA[2], voffB[2];
#pragma unroll
    for (int i = 0; i < 2; ++i) { int R, C; stage_rc(tid * 16 + i * 8192, R, C); const int Rb = Epi::PERM ? ((R & ~31) + perm32(R & 31)) : R;
        voffA[i] = (unsigned)(R * K + C) * 2u; voffB[i] = (unsigned)(Rb * K + C) * 2u; }
    const size_t kstep = (size_t)(BK * 2);
    const size_t hstep = (size_t)HALF * K * 2;
    const size_t tstep = 2 * hstep;
    const unsigned ldsw = (unsigned)wid * 1024u;
    const int aoff = lds_byte(wr * 64 + fr, fq * 8), boff = lds_byte(wc * 32 + fr, fq * 8);
#define PG8_SA(b, h) (((b) * 2 + (h)) * HTB)
#define PG8_SB(b, h) ((4 + (b) * 2 + (h)) * HTB)
#ifndef PG8_AUX_A
#define PG8_AUX_A 0
#endif
#ifndef PG8_AUX_B
#define PG8_AUX_B 0
#endif
#define PG8_STAGE_X(bufoff, gbase, voff, AUX) do { _Pragma("unroll") for (int _i = 0; _i < 2; ++_i) \
        __builtin_amdgcn_global_load_lds((const unsigned*)((const char*)(gbase) + (voff)[_i]), (PG8_LAS unsigned*)(lds + (bufoff) + ldsw + _i * 8192), 16, 0, AUX); } while (0)
#define PG8_STAGE(bufoff, gbase, voff) PG8_STAGE_X(bufoff, gbase, voff, PG8_AUX_A)
#define PG8_STAGEB(bufoff, gbase, voff) PG8_STAGE_X(bufoff, gbase, voff, PG8_AUX_B)
#define PG8_LDA(dst, b, h) do { _Pragma("unroll") for (int m = 0; m < 4; ++m) _Pragma("unroll") for (int k = 0; k < 2; ++k) dst[m][k] = *(const PG8_LAS bf16x8*)(lds + PG8_SA(b, h) + aoff + m * 2048 + k * 1024); } while (0)
#define PG8_LDB(dst, b, h) do { _Pragma("unroll") for (int n = 0; n < 2; ++n) _Pragma("unroll") for (int k = 0; k < 2; ++k) dst[n][k] = *(const PG8_LAS bf16x8*)(lds + PG8_SB(b, h) + boff + n * 2048 + k * 1024); } while (0)
#define PG8_MMA(ai, bj, At, Bt) do { __builtin_amdgcn_s_setprio(1); _Pragma("unroll") for (int m = 0; m < 4; ++m) _Pragma("unroll") for (int n = 0; n < 2; ++n) _Pragma("unroll") for (int k = 0; k < 2; ++k) \
        acc[ai][bj][m][n] = __builtin_amdgcn_mfma_f32_16x16x32_bf16(Bt[n][k], At[m][k], acc[ai][bj][m][n], 0, 0, 0); __builtin_amdgcn_s_setprio(0); } while (0)
#define PG8_WAIT_V(n) asm volatile("s_waitcnt vmcnt(" #n ")" ::: "memory")
#define PG8_WAIT_L(n) asm volatile("s_waitcnt lgkmcnt(" #n ")" ::: "memory")
#define PG8_BAR __builtin_amdgcn_s_barrier()
#define PG8_SCHED __builtin_amdgcn_sched_barrier(0)
    Unit cur, nxt; int ui = 0;
    if (!S.next(0, cur)) return;
    f32x4 acc[2][2][4][2];
#pragma unroll
    for (int a = 0; a < 2; ++a)
#pragma unroll
        for (int b = 0; b < 2; ++b)
#pragma unroll
            for (int m = 0; m < 4; ++m)
#pragma unroll
                for (int n = 0; n < 2; ++n) acc[a][b][m][n] = (f32x4){0.f, 0.f, 0.f, 0.f};
    bf16x8 At[4][2], B0[2][2], B1[2][2];
    const char* cA = (const char*)g.A + (size_t)cur.pm * tstep; const char* cB = (const char*)g.Bt + (size_t)cur.pn * tstep;
    S.a_ready(cur);
    if constexpr (SP2) {
        pre.issue(tid);
        PG8_STAGEB(PG8_SB(0, 0), cB, voffB); PG8_STAGEB(PG8_SB(0, 1), cB + hstep, voffB); PG8_STAGE(PG8_SA(0, 0), cA, voffA); PG8_STAGE(PG8_SA(0, 1), cA + hstep, voffA);
        pre.finish(tid);
        if (wr == 1) PG8_BAR;
        PG8_WAIT_V(2); PG8_BAR;
        PG8_STAGEB(PG8_SB(1, 0), cB + kstep, voffB); PG8_STAGE(PG8_SA(1, 0), cA + kstep, voffA); PG8_STAGEB(PG8_SB(1, 1), cB + hstep + kstep, voffB);
        PG8_WAIT_V(6); PG8_BAR;
    } else {
        PG8_STAGEB(PG8_SB(0, 0), cB, voffB); PG8_STAGE(PG8_SA(0, 0), cA, voffA); PG8_STAGEB(PG8_SB(0, 1), cB + hstep, voffB); PG8_STAGE(PG8_SA(0, 1), cA + hstep, voffA);
        if (wr == 1) PG8_BAR;
        PG8_WAIT_V(4); PG8_BAR;
        PG8_STAGEB(PG8_SB(1, 0), cB + kstep, voffB); PG8_STAGE(PG8_SA(1, 0), cA + kstep, voffA); PG8_STAGEB(PG8_SB(1, 1), cB + hstep + kstep, voffB);
        PG8_WAIT_V(6); PG8_BAR;
    }
    for (;;) {
        const bool has_next = S.next(ui + 1, nxt);
        const char* nA = has_next ? (const char*)g.A + (size_t)nxt.pm * tstep : cA; const char* nB = has_next ? (const char*)g.Bt + (size_t)nxt.pn * tstep : cB;
        for (int t = 0; t < nt; t += 2) {
            const bool last = (t == nt - 2);
            const char* a1 = cA + (size_t)(t + 1) * kstep;
            const char* a2 = last ? nA : cA + (size_t)(t + 2) * kstep; const char* b2 = last ? nB : cB + (size_t)(t + 2) * kstep;
            const char* a3 = a2 + kstep; const char* b3 = b2 + kstep;
            if (last && has_next) S.a_ready(nxt);
            if constexpr (SP2) {
            PG8_LDB(B0, 0, 0); PG8_LDB(B1, 0, 1); PG8_SCHED; PG8_LDA(At, 0, 0); PG8_STAGE(PG8_SA(1, 1), a1 + hstep, voffA);
            PG8_WAIT_V(8); PG8_WAIT_L(0); PG8_BAR; PG8_MMA(0, 0, At, B0); PG8_MMA(0, 1, At, B1); PG8_BAR; PG8_SCHED;
            PG8_LDA(At, 0, 1); PG8_STAGEB(PG8_SB(0, 0), b2, voffB); PG8_STAGEB(PG8_SB(0, 1), b2 + hstep, voffB); PG8_STAGE(PG8_SA(0, 0), a2, voffA);
            PG8_WAIT_V(8); PG8_WAIT_L(0); PG8_BAR; PG8_MMA(1, 0, At, B0); PG8_MMA(1, 1, At, B1); PG8_BAR; PG8_SCHED;
            PG8_LDB(B0, 1, 0); PG8_LDB(B1, 1, 1); PG8_SCHED; PG8_LDA(At, 1, 0); PG8_STAGE(PG8_SA(0, 1), a2 + hstep, voffA);
            PG8_WAIT_V(8); PG8_WAIT_L(0); PG8_BAR; PG8_MMA(0, 0, At, B0); PG8_MMA(0, 1, At, B1); PG8_BAR; PG8_SCHED;
            PG8_LDA(At, 1, 1); PG8_STAGEB(PG8_SB(1, 0), b3, voffB); PG8_STAGEB(PG8_SB(1, 1), b3 + hstep, voffB); PG8_STAGE(PG8_SA(1, 0), a3, voffA);
            PG8_WAIT_V(8); PG8_WAIT_L(0); PG8_BAR; PG8_MMA(1, 0, At, B0); PG8_MMA(1, 1, At, B1); PG8_BAR; PG8_SCHED;
            } else {
            PG8_LDB(B0, 0, 0); PG8_SCHED; PG8_LDA(At, 0, 0); PG8_STAGE(PG8_SA(1, 1), a1 + hstep, voffA);
            PG8_WAIT_L(8); PG8_BAR; PG8_WAIT_L(0); PG8_MMA(0, 0, At, B0); PG8_BAR; PG8_SCHED;
            PG8_LDB(B1, 0, 1); PG8_STAGEB(PG8_SB(0, 0), b2, voffB);
            PG8_BAR; PG8_WAIT_L(0); PG8_MMA(0, 1, At, B1); PG8_BAR;
            PG8_LDA(At, 0, 1); PG8_STAGE(PG8_SA(0, 0), a2, voffA);
            PG8_BAR; PG8_WAIT_L(0); PG8_MMA(1, 0, At, B0); PG8_BAR; PG8_SCHED;
            PG8_STAGEB(PG8_SB(0, 1), b2 + hstep, voffB);
            PG8_WAIT_V(6); PG8_BAR; PG8_MMA(1, 1, At, B1); PG8_BAR;
            PG8_LDB(B0, 1, 0); PG8_SCHED; PG8_LDA(At, 1, 0); PG8_STAGE(PG8_SA(0, 1), a2 + hstep, voffA);
            PG8_WAIT_L(8); PG8_BAR; PG8_WAIT_L(0); PG8_MMA(0, 0, At, B0); PG8_BAR; PG8_SCHED;
            PG8_LDB(B1, 1, 1); PG8_STAGEB(PG8_SB(1, 0), b3, voffB);
            PG8_BAR; PG8_WAIT_L(0); PG8_MMA(0, 1, At, B1); PG8_BAR;
            PG8_LDA(At, 1, 1); PG8_STAGE(PG8_SA(1, 0), a3, voffA);
            PG8_BAR; PG8_WAIT_L(0); PG8_MMA(1, 0, At, B0); PG8_BAR; PG8_SCHED;
            PG8_STAGEB(PG8_SB(1, 1), b3 + hstep, voffB);
            PG8_WAIT_V(6); PG8_BAR; PG8_MMA(1, 1, At, B1); PG8_BAR;
            }
        }
        if constexpr (ALIGN_EPI) { if (wr == 0) PG8_BAR; }
        if constexpr (!Epi::AFTER_DRAIN) { E(acc, cur, wr, wc, fr, fq); S.done(cur); }
        if (!has_next) break;
#pragma unroll
        for (int a = 0; a < 2; ++a)
#pragma unroll
            for (int b = 0; b < 2; ++b)
#pragma unroll
                for (int m = 0; m < 4; ++m)
#pragma unroll
                    for (int n = 0; n < 2; ++n) acc[a][b][m][n] = (f32x4){0.f, 0.f, 0.f, 0.f};
        cur = nxt; cA = nA; cB = nB; ++ui;
        if constexpr (ALIGN_EPI) { if (wr == 1) PG8_BAR; }
    }
    PG8_WAIT_V(0);
    if constexpr (!ALIGN_EPI) { if (wr == 0) PG8_BAR; }
    PG8_BAR;
    if constexpr (Epi::AFTER_DRAIN) { E.fused(acc, cur, wr, wc, fr, fq, lds, wid, lane); S.done(cur); }
#undef PG8_SA
#undef PG8_SB
#undef PG8_STAGE
#undef PG8_STAGEB
#undef PG8_STAGE_X
#undef PG8_LDA
#undef PG8_LDB
#undef PG8_MMA
#undef PG8_WAIT_V
#undef PG8_WAIT_L
#undef PG8_BAR
#undef PG8_SCHED
}
}

#ifndef PG8_SP2
#define PG8_SP2 true
#endif
#ifndef PG8_ALIGN
#define PG8_ALIGN true
#endif
#include <hip/hip_bf16.h>
#include <cmath>
namespace attn_body {
using bf16=__hip_bfloat16;
using bf16x8=__attribute__((ext_vector_type(8)))short;
using s16x4=__attribute__((ext_vector_type(4)))short;
using f32x16=__attribute__((ext_vector_type(16)))float;
using u32x4=__attribute__((ext_vector_type(4)))unsigned;
constexpr int BATCH=8,NHEAD=16,SEQ=2048,D=64,DM=NHEAD*D;
constexpr int NW=8,QBLK=32,QB=QBLK*NW,KVBLK=64,NQB=SEQ/QB;
constexpr int ATTN_PITCH=DM, ATTN_UNIT_ROWS=QB;
__device__ __forceinline__ int crow(int r,int hi){return (r&3)+8*(r>>2)+4*hi;}
#define SBAR() __builtin_amdgcn_sched_barrier(0)
__device__ __forceinline__ void cmask(f32x16&p0,f32x16&p1,int jb,int qrel,int hi){
  const float NEG=-INFINITY; int kb=64*jb+4*hi;
  #pragma unroll
  for(int r=0;r<16;++r){int kv=kb+(r&3)+8*(r>>2); if(kv>qrel)p0[r]=NEG; if(kv+32>qrel)p1[r]=NEG;}
}

constexpr int NSLOT=3, SLOTB=8192;
constexpr int LDS_K=0, LDS_V=NSLOT*SLOTB, LDS_WS=2*NSLOT*SLOTB, LDS_OST=LDS_WS+NW*64*4, LDS_CB=LDS_OST+NW*4096, LDS_BYTES=LDS_CB+SEQ*4;
constexpr float C2=0.125f*1.4426950408889634f;
__device__ __forceinline__ void glds16(const void*gsrc,unsigned lds_dst){unsigned keep;
  asm volatile("s_mov_b32 %0, m0\n\ts_mov_b32 m0, %2\n\ts_nop 0\n\tglobal_load_lds_dwordx4 %1, off\n\ts_mov_b32 m0, %0":"=&s"(keep):"v"(gsrc),"s"(lds_dst):"memory");}
__device__ __forceinline__ float max3f(float a,float b,float c){float r;asm("v_max3_f32 %0, %1, %2, %3":"=v"(r):"v"(a),"v"(b),"v"(c));return r;}
__device__ __forceinline__ float max2f(float a,float b){float r;asm("v_max_f32_e32 %0, %1, %2":"=v"(r):"v"(a),"v"(b));return r;}
__device__ __forceinline__ float fadd_s(float a,float b){float r;asm("v_add_f32_e32 %0, %1, %2":"=v"(r):"v"(a),"v"(b));return r;}
__device__ __forceinline__ float fsub_s(float a,float b){float r;asm("v_sub_f32_e32 %0, %1, %2":"=v"(r):"v"(a),"v"(b));return r;}
typedef float f32x2_t __attribute__((ext_vector_type(2))); typedef __bf16 bf16x2_t __attribute__((ext_vector_type(2)));
__device__ __forceinline__ unsigned cvtpk_s(float lo,float hi){f32x2_t v={lo,hi};bf16x2_t b=__builtin_convertvector(v,bf16x2_t);return __builtin_bit_cast(unsigned,b);}
#define WAIT_BAR(N) asm volatile("s_waitcnt vmcnt(" #N ") lgkmcnt(0)\n\ts_barrier":::"memory")

__device__ __forceinline__ void qkt(f32x16&p0,f32x16&p1,const char*Kslot,const bf16x8*qr,int r32,int hi){
  const char*kb=Kslot+hi*1024+r32*16;
  #pragma unroll
  for(int d0=0;d0<4;++d0){
    const bf16x8 b0=*reinterpret_cast<const bf16x8*>(kb+d0*2048);
    const bf16x8 b1=*reinterpret_cast<const bf16x8*>(kb+d0*2048+512);
    {p0=__builtin_amdgcn_mfma_f32_32x32x16_bf16(b0,qr[d0],p0,0,0,0);p1=__builtin_amdgcn_mfma_f32_32x32x16_bf16(b1,qr[d0],p1,0,0,0);}}
}
typedef __attribute__((address_space(3))) const char* lds_cptr;
typedef short v4i16_t __attribute__((ext_vector_type(4)));
__device__ __forceinline__ void kload8(bf16x8*kf,lds_cptr kp){
  kf[0]=*(const __attribute__((address_space(3))) bf16x8*)(kp);      kf[1]=*(const __attribute__((address_space(3))) bf16x8*)(kp+512);
  kf[2]=*(const __attribute__((address_space(3))) bf16x8*)(kp+2048); kf[3]=*(const __attribute__((address_space(3))) bf16x8*)(kp+2560);
  kf[4]=*(const __attribute__((address_space(3))) bf16x8*)(kp+4096); kf[5]=*(const __attribute__((address_space(3))) bf16x8*)(kp+4608);
  kf[6]=*(const __attribute__((address_space(3))) bf16x8*)(kp+6144); kf[7]=*(const __attribute__((address_space(3))) bf16x8*)(kp+6656);
}
__device__ __forceinline__ void kload2(bf16x8*kf,lds_cptr kp,int j){ kf[2*j]=*(const __attribute__((address_space(3))) bf16x8*)(kp+j*2048); kf[2*j+1]=*(const __attribute__((address_space(3))) bf16x8*)(kp+j*2048+512); }
__device__ __forceinline__ s16x4 vtr(lds_cptr p){ return __builtin_bit_cast(s16x4,__builtin_amdgcn_ds_read_tr16_b64_v4i16((__attribute__((address_space(3))) v4i16_t*)p)); }
__device__ __forceinline__ float rowmax(const f32x16&p0,const f32x16&p1){
  float a=max3f(p0[0],p0[1],p1[0]),b=max3f(p0[2],p0[3],p1[1]);a=max3f(a,p1[2],p1[3]);
  #pragma unroll
  for(int r=4;r<16;r+=4){a=max3f(a,p0[r],p0[r+1]);b=max3f(b,p0[r+2],p0[r+3]);a=max3f(a,p1[r],p1[r+1]);b=max3f(b,p1[r+2],p1[r+3]);}
  const float m=max2f(a,b);
  auto rr=__builtin_amdgcn_permlane32_swap(__float_as_uint(m),__float_as_uint(m),false,false);
  return max2f(__uint_as_float(rr[0]),__uint_as_float(rr[1]));
}
__device__ __forceinline__ void pv(f32x16*o,int vb,bf16x8 pa0,bf16x8 pa1,bf16x8 pa2,bf16x8 pa3){
  #pragma unroll
  for(int d0=0;d0<2;++d0){s16x4 lo[4],hi[4];
    #pragma unroll
    for(int ks=0;ks<4;++ks){
      asm volatile("ds_read_b64_tr_b16 %0,%1 offset:%c2":"=&v"(lo[ks]):"v"(vb),"i"(d0*4096+ks*1024):"memory");
      asm volatile("ds_read_b64_tr_b16 %0,%1 offset:%c2":"=&v"(hi[ks]):"v"(vb),"i"(d0*4096+ks*1024+512):"memory");}
    asm volatile("s_waitcnt lgkmcnt(0)":::"memory");SBAR();
    #define PK(k) (bf16x8){lo[k][0],lo[k][1],lo[k][2],lo[k][3],hi[k][0],hi[k][1],hi[k][2],hi[k][3]}
    o[d0]=__builtin_amdgcn_mfma_f32_32x32x16_bf16(pa0,PK(0),o[d0],0,0,0);
    o[d0]=__builtin_amdgcn_mfma_f32_32x32x16_bf16(pa1,PK(1),o[d0],0,0,0);
    o[d0]=__builtin_amdgcn_mfma_f32_32x32x16_bf16(pa2,PK(2),o[d0],0,0,0);
    o[d0]=__builtin_amdgcn_mfma_f32_32x32x16_bf16(pa3,PK(3),o[d0],0,0,0);
    #undef PK
  }
}

#ifndef ATTN_STORE16
#define ATTN_STORE16(p,v) pg8::st16((void*)(p),(v))
#define ATTN_STORE16_PLAIN(p,v) (*(u32x4*)(p)=(v))
#endif
template<int THRL> __device__ __forceinline__ void attn_unit(int b,int h,int qb,const bf16*Q,const bf16*__restrict__ K,const bf16*__restrict__ V,bf16*O,const float*LOGF,char*shm,const int wv,const bool scan){
  const int tid=mk_ltid(wv),lane=tid&63,r32=lane&31,hi=lane>>5; const int wid=__builtin_amdgcn_readfirstlane(tid>>6);
  const long rowbase=(long)b*SEQ; const int q0=qb*QB;
  const bf16*Qw=Q+(rowbase+q0+wid*QBLK)*DM+h*D;
  const bf16*Kh=K+rowbase*DM+h*D,*Vh=V+rowbase*DM+h*D;
  const lds_cptr shm3=(lds_cptr)shm; const unsigned lds0=(unsigned)(uintptr_t)shm;
  float*wsf=(float*)(shm+LDS_WS)+wid*64;
  const bf16*ksrc=Kh+(long)lane*DM+wid*8;
  const bf16*vsrc=Vh+(long)(16*(wid&3)+(lane>>2))*DM+(wid>>2)*32+(lane&3)*8;
  const unsigned kdst=lds0+LDS_K+wid*1024, vdst=lds0+LDS_V+wid*1024;
  #define DMA_K(t,slot) glds16(ksrc+(long)(t)*KVBLK*DM,(unsigned)__builtin_amdgcn_readfirstlane(kdst+(slot)))
  #define DMA_V(t,slot) glds16(vsrc+(long)(t)*KVBLK*DM,(unsigned)__builtin_amdgcn_readfirstlane(vdst+(slot)))
  const int vb0=(int)(lds0+LDS_V)+((lane>>4)&1)*32+(lane&3)*8+(4*hi+((lane&15)>>2))*64;
  const char*Kbase=shm+LDS_K; bf16x8 kf[8];
  const lds_cptr kp0=shm3+LDS_K+hi*1024+r32*16; const lds_cptr vp0=shm3+LDS_V+((lane>>4)&1)*32+(lane&3)*8+(4*hi+((lane&15)>>2))*64;
  const int NT=(q0+QB)/KVBLK;
  if(scan){ typedef __attribute__((address_space(3))) float lf32; typedef float f32x4_t __attribute__((ext_vector_type(4)));
    lf32*cbw=(lf32*)(shm3+LDS_CB); lf32*tot=(lf32*)(shm3+LDS_WS);
    const float*lfp=LOGF+(long)(b*NHEAD+h)*SEQ; const bool act=(4*tid<SEQ);
    f32x4_t v={0.f,0.f,0.f,0.f}; if(act)v=*(const f32x4_t*)(lfp+4*tid);
    v[1]+=v[0];v[2]+=v[1];v[3]+=v[2]; float s=v[3];
    _Pragma("unroll") for(int o=1;o<64;o<<=1){const float n_=__shfl_up(s,o); if(lane>=o)s+=n_;}
    if(lane==63)tot[wid]=s;
    __syncthreads();
    float base=s-v[3]; for(int w=0;w<wid;++w)base+=tot[w];
    if(act)*(__attribute__((address_space(3))) f32x4_t*)(cbw+4*tid)=(f32x4_t){v[0]+base,v[1]+base,v[2]+base,v[3]+base};
    __syncthreads(); }
  DMA_K(0,0);DMA_V(0,0);DMA_K(1,SLOTB);
  bf16x8 qr[4];
  #pragma unroll
  for(int d0=0;d0<4;++d0)qr[d0]=*reinterpret_cast<const bf16x8*>(&Qw[(long)r32*DM+d0*16+hi*8]);
  float mhat=0.f,l_reg=0.f,nm=0.f;f32x16 o[2];o[0]=f32x16{};o[1]=f32x16{};
  typedef float f32x4_t __attribute__((ext_vector_type(4)));
  const __attribute__((address_space(3))) float* cbl=(const __attribute__((address_space(3))) float*)(shm3+LDS_CB)+4*hi;
  #define CBINIT1(C,t,off) do{ const __attribute__((address_space(3))) float* cbt_=cbl+64*(t)+(off); \
    _Pragma("unroll") for(int g_=0;g_<4;++g_){ const f32x4_t b_=*(const __attribute__((address_space(3))) f32x4_t*)(cbt_+8*g_); \
      _Pragma("unroll") for(int j_=0;j_<4;++j_){ C[4*g_+j_]=nm-b_[j_]; } } }while(0)
  #define CBINIT(C0,C1,t) do{ CBINIT1(C0,t,0); CBINIT1(C1,t,32); }while(0)
  const int qrel=wid*QBLK+r32;
  { const float cbq=((const __attribute__((address_space(3))) float*)(shm3+LDS_CB))[q0+qrel]; mhat=-cbq; nm=cbq; }
  #define CMASK(P0,P1,t) do{int jb_=(t)-(NT-4); if(jb_>=0)cmask(P0,P1,jb_,qrel,hi);}while(0)
  bool resc=false;
  #define START(P0,P1) do{ const float rm=rowmax(P0,P1); resc=false; \
    if(__any(rm>(float)THRL)){ const float dl=__builtin_fmaxf(rm,0.f); mhat=fadd_s(mhat,dl); \
      _Pragma("unroll") for(int r=0;r<16;++r){P0[r]=fsub_s(P0[r],dl);P1[r]=fsub_s(P1[r],dl);} \
      nm=-mhat; } \
    _Pragma("unroll") for(int r=0;r<16;++r)P0[r]=__builtin_amdgcn_exp2f(P0[r]); }while(0)
  #define RESC() do{ if(resc){ asm volatile("s_waitcnt lgkmcnt(0)":::"memory"); \
      _Pragma("unroll") for(int d_=0;d_<2;++d_) _Pragma("unroll") for(int r=0;r<16;++r)o[d_][r]*=wsf[crow(r,hi)]; } }while(0)
  f32x16 pA0,pA1,pB0,pB1;
  int sl_prev=0,sl_cur=0,sl_next=SLOTB;
  #define ROT() do{sl_prev=sl_cur;sl_cur=sl_next;sl_next=(sl_next==(NSLOT-1)*SLOTB)?0:sl_next+SLOTB;}while(0)
  DMA_K(2,2*SLOTB);
  WAIT_BAR(3);
  CBINIT(pA0,pA1,0); qkt(pA0,pA1,Kbase,qr,r32,hi);asm volatile("s_nop 15\n\ts_nop 7":"+v"(pA0),"+v"(pA1));CMASK(pA0,pA1,0);
  START(pA0,pA1);
  _Pragma("unroll") for(int r=0;r<16;++r)pA1[r]=__builtin_amdgcn_exp2f(pA1[r]);
  WAIT_BAR(0);
  DMA_K(3,0);DMA_V(1,SLOTB);
  ROT();
  kload8(kf,kp0+sl_cur);
  WAIT_BAR(2);
  s16x4 vlo[8],vhi[8]; u32x4 pw0,pw1,pw2,pw3;
  #define PKW(P,B) cvtpk_s(P[B],P[B+1])
  #define PAF(k) __builtin_bit_cast(bf16x8,pw##k)
  #define VFR(i) (bf16x8){vlo[i][0],vlo[i][1],vlo[i][2],vlo[i][3],vhi[i][0],vhi[i][1],vhi[i][2],vhi[i][3]}
  #define PIN(x) asm volatile("":"+v"(x))
  #define MX3(a,b,c) __builtin_fmaxf(__builtin_fmaxf((a),(b)),(c))
  #define GAPA(MF,A0,A1,A2,A3,W0,W1,PW) do{ MF; sacc+=A0; sacc+=A1; sacc+=A2; sacc+=A3; PIN(sacc); W0; W1; PIN(PW); SBAR(); }while(0)
  #define EX(v) __builtin_amdgcn_exp2f(v)
  #define GAPB(MF,X,B) do{ MF; X[B]=EX(X[B]); X[B+1]=EX(X[B+1]); X[B+2]=EX(X[B+2]); X[B+3]=EX(X[B+3]); PIN(X); SBAR(); }while(0)
  #define VRD(i) do{ vlo[i]=vtr(vp_+(((i)>>2)*4096+((i)&3)*1024)); vhi[i]=vtr(vp_+(((i)>>2)*4096+((i)&3)*1024+512)); }while(0)
  #define KRD(G,j) do{ if(G){ kload2(kf,kp0+sl_next,j); SBAR(); } }while(0)
  #define STEP(C0,C1,P0,P1,t,GK,GV,GL) do{ SBAR(); CBINIT1(C0,t,0); SBAR(); \
    const lds_cptr vp_=vp0+sl_prev; \
    VRD(0); SBAR(); float sacc=(P0[0]+P0[1]); \
    GAPA(C0=__builtin_amdgcn_mfma_f32_32x32x16_bf16(kf[0],qr[0],C0,0,0,0), P0[2],P0[3],P0[4],P0[5],     pw0[0]=PKW(P0,0), pw0[1]=PKW(P0,2), pw0); \
    CBINIT1(C1,t,32); VRD(4); SBAR(); GAPA(C1=__builtin_amdgcn_mfma_f32_32x32x16_bf16(kf[1],qr[0],C1,0,0,0), P0[6],P0[7],P0[8],P0[9],     pw0[2]=PKW(P0,4), pw0[3]=PKW(P0,6), pw0); \
    VRD(1); SBAR(); GAPA(C0=__builtin_amdgcn_mfma_f32_32x32x16_bf16(kf[2],qr[1],C0,0,0,0),   P0[10],P0[11],P0[12],P0[13], pw1[0]=PKW(P0,8), pw1[1]=PKW(P0,10), pw1); \
    VRD(5); SBAR(); GAPA(C1=__builtin_amdgcn_mfma_f32_32x32x16_bf16(kf[3],qr[1],C1,0,0,0),   P0[14],P0[15],P1[0],P1[1],   pw1[2]=PKW(P0,12),pw1[3]=PKW(P0,14), pw1); \
    VRD(2); SBAR(); GAPA(C0=__builtin_amdgcn_mfma_f32_32x32x16_bf16(kf[4],qr[2],C0,0,0,0),   P1[2],P1[3],P1[4],P1[5],     pw2[0]=PKW(P1,0), pw2[1]=PKW(P1,2), pw2); \
    VRD(6); SBAR(); GAPA(C1=__builtin_amdgcn_mfma_f32_32x32x16_bf16(kf[5],qr[2],C1,0,0,0),   P1[6],P1[7],P1[8],P1[9],     pw2[2]=PKW(P1,4), pw2[3]=PKW(P1,6), pw2); \
    VRD(3); SBAR(); GAPA(C0=__builtin_amdgcn_mfma_f32_32x32x16_bf16(kf[6],qr[3],C0,0,0,0),   P1[10],P1[11],P1[12],P1[13], pw3[0]=PKW(P1,8), pw3[1]=PKW(P1,10), pw3); \
    VRD(7); SBAR(); GAPA(C1=__builtin_amdgcn_mfma_f32_32x32x16_bf16(kf[7],qr[3],C1,0,0,0),   P1[14],P1[15],0.f,0.f,       pw3[2]=PKW(P1,12),pw3[3]=PKW(P1,14), pw3); \
    l_reg+=sacc; \
    if(GK){DMA_K((t)+3,sl_cur);} if(GV){DMA_V((t)+1,sl_next);} \
    CMASK(C0,C1,t); \
    { float a=MX3(C0[0],C0[1],C1[0]),b=MX3(C0[2],C0[3],C1[1]); a=MX3(a,C1[2],C1[3]); \
      _Pragma("unroll") for(int r=4;r<16;r+=4){a=MX3(a,C0[r],C0[r+1]);b=MX3(b,C0[r+2],C0[r+3]);a=MX3(a,C1[r],C1[r+1]);b=MX3(b,C1[r+2],C1[r+3]);} \
      float rm=__builtin_fmaxf(a,b); { auto rr=__builtin_amdgcn_permlane32_swap(__float_as_uint(rm),__float_as_uint(rm),false,false); rm=__builtin_fmaxf(__uint_as_float(rr[0]),__uint_as_float(rr[1])); } \
      resc=false; \
      if(__builtin_expect(__any(rm>(float)THRL),0)){ const float dl=__builtin_fmaxf(rm,0.f); mhat+=dl; \
        _Pragma("unroll") for(int r=0;r<16;++r){C0[r]-=dl;C1[r]-=dl;} \
        nm=-mhat; \
        const float f=__builtin_amdgcn_exp2f(-dl); l_reg*=f; if(hi==0)wsf[r32]=f; resc=true; } } \
    SBAR(); \
    GAPB(o[0]=__builtin_amdgcn_mfma_f32_32x32x16_bf16(PAF(0),VFR(0),o[0],0,0,0), C0,0); \
    GAPB(o[1]=__builtin_amdgcn_mfma_f32_32x32x16_bf16(PAF(0),VFR(4),o[1],0,0,0), C0,4); \
    KRD(GL,0); GAPB(o[0]=__builtin_amdgcn_mfma_f32_32x32x16_bf16(PAF(1),VFR(1),o[0],0,0,0), C0,8); \
    KRD(GL,1); GAPB(o[1]=__builtin_amdgcn_mfma_f32_32x32x16_bf16(PAF(1),VFR(5),o[1],0,0,0), C0,12); \
    KRD(GL,2); GAPB(o[0]=__builtin_amdgcn_mfma_f32_32x32x16_bf16(PAF(2),VFR(2),o[0],0,0,0), C1,0); \
    KRD(GL,3); GAPB(o[1]=__builtin_amdgcn_mfma_f32_32x32x16_bf16(PAF(2),VFR(6),o[1],0,0,0), C1,4); \
    GAPB(o[0]=__builtin_amdgcn_mfma_f32_32x32x16_bf16(PAF(3),VFR(3),o[0],0,0,0), C1,8); \
    GAPB(o[1]=__builtin_amdgcn_mfma_f32_32x32x16_bf16(PAF(3),VFR(7),o[1],0,0,0), C1,12); \
    }while(0)
  int t=1;
  #undef CMASK
  #define CMASK(P0,P1,t) do{}while(0)
  for(;t+5<NT;t+=2){
    STEP(pB0,pB1,pA0,pA1,t,true,true,true);     WAIT_BAR(2); RESC(); ROT();
    STEP(pA0,pA1,pB0,pB1,t+1,true,true,true);   WAIT_BAR(2); RESC(); ROT();
  }
  #undef CMASK
  #define CMASK(P0,P1,t) do{int jb_=(t)-(NT-4); if(jb_>=0)cmask(P0,P1,jb_,qrel,hi);}while(0)
  #define ENDW(tt) do{ if((tt)+3<NT){WAIT_BAR(2);} else if((tt)+2<NT){WAIT_BAR(1);} else {WAIT_BAR(0);} }while(0)
  for(;t+1<NT;t+=2){
    STEP(pB0,pB1,pA0,pA1,t,(t+3<NT),(t+1<NT),(t+1<NT));       ENDW(t);   RESC(); ROT();
    STEP(pA0,pA1,pB0,pB1,t+1,(t+4<NT),(t+2<NT),(t+2<NT));     ENDW(t+1); RESC(); ROT();
  }
  STEP(pB0,pB1,pA0,pA1,NT-1,false,false,false); RESC();
  { float sacc=pB0[0]+pB0[1]; _Pragma("unroll") for(int r=2;r<16;++r)sacc+=pB0[r]; _Pragma("unroll") for(int r=0;r<16;++r)sacc+=pB1[r]; l_reg+=sacc;
    pw0=(u32x4){PKW(pB0,0),PKW(pB0,2),PKW(pB0,4),PKW(pB0,6)};pw1=(u32x4){PKW(pB0,8),PKW(pB0,10),PKW(pB0,12),PKW(pB0,14)};pw2=(u32x4){PKW(pB1,0),PKW(pB1,2),PKW(pB1,4),PKW(pB1,6)};pw3=(u32x4){PKW(pB1,8),PKW(pB1,10),PKW(pB1,12),PKW(pB1,14)};
    SBAR(); pv(o,vb0+sl_cur,PAF(0),PAF(1),PAF(2),PAF(3)); }
  #undef PKW
  #undef PAF
  #undef VFR
  #undef PIN
  #undef MX3
  #undef GAPA
  #undef GAPB
  #undef EX
  #undef VRD
  #undef KRD
  #undef STEP
  #undef ENDW
  {auto rr=__builtin_amdgcn_permlane32_swap(__float_as_uint(l_reg),__float_as_uint(l_reg),false,false);l_reg=__uint_as_float(rr[0])+__uint_as_float(rr[1]);}
  if(hi==0)wsf[32+r32]=l_reg;asm volatile("s_waitcnt lgkmcnt(0)":::"memory");
  float rli[16];
  #pragma unroll
  for(int r=0;r<16;++r)rli[r]=__builtin_amdgcn_rcpf(wsf[32+crow(r,hi)]);
  bf16*Ow=O+(rowbase+q0+wid*QBLK)*DM+h*D;
  { bf16*stg=(bf16*)(shm+LDS_OST)+wid*2048;
    #pragma unroll
    for(int r=0;r<16;++r){const int orow=crow(r,hi);
      #pragma unroll
      for(int d0=0;d0<2;++d0)stg[orow*64+d0*32+r32]=__float2bfloat16(o[d0][r]*rli[r]);}
    asm volatile("s_waitcnt lgkmcnt(0)":::"memory");
    #pragma unroll
    for(int i=0;i<4;++i){const int row=i*8+(lane>>3),ch=lane&7; const u32x4 v=*(const u32x4*)(stg+row*64+ch*8); ATTN_STORE16(Ow+(long)row*DM+ch*8,v);} }
  asm volatile("s_waitcnt lgkmcnt(0)\n\ts_barrier":::"memory");
  #undef DMA_K
  #undef DMA_V
  #undef CMASK
  #undef START
  #undef RESC
  #undef ROT
  #undef CBINIT
  #undef CBINIT1
}
constexpr int ATTN_LDS_BYTES=LDS_BYTES;
struct AttnTensors { const bf16* Q; const bf16* K; const bf16* V; bf16* O; const float* LOGF; };
struct AttnUnit { int bh; int qb; };
struct StaticOrder {
  int vcu,G;
  __device__ __forceinline__ explicit StaticOrder(int grid,int block):vcu((grid%8==0)?(block%8)*(grid/8)+block/8:block),G(grid){}
  __device__ __forceinline__ bool next(int i,AttnUnit&u)const{
    if(G==256){ if(i>=4)return false; const int s=vcu&1; u.bh=vcu>>1; u.qb=(i==0)?7-s:(i==1)?s:(i==2)?4+s:3-s; return true; }
    const int idx=vcu+i*G; if(idx>=BATCH*NHEAD*NQB)return false; u.bh=idx/NQB; u.qb=NQB-1-(idx%NQB); return true; }
  __device__ __forceinline__ void a_ready(const AttnUnit&)const{}
  __device__ __forceinline__ void done(const AttnUnit&)const{}
};
template<class Sched,int THRL=8> __device__ __forceinline__ void attn_phase(char*lds,const AttnTensors&T,const Sched&S,const int wv){
  AttnUnit u;
  int last_bh=-1;
  for(int i=0;S.next(i,u);++i){ S.a_ready(u); attn_unit<THRL>(u.bh/NHEAD,u.bh%NHEAD,u.qb,T.Q,T.K,T.V,T.O,T.LOGF,lds,wv,u.bh!=last_bh); last_bh=u.bh; S.done(u); }
}
#undef SBAR
#undef WAIT_BAR
}

namespace cg = cooperative_groups;
constexpr int NWAVES = 8;
constexpr int BATCH = 8, SEQ = 2048, D = 1024, M = BATCH * SEQ, DEPTH = 4, DFF = 2816;
constexpr float EPS = 1e-6f, LOG2E = 1.4426950408889634f;
constexpr size_t MiB = 1u << 20;
constexpr size_t WS_SSQ = 1 * MiB;
constexpr size_t WS_LOGF = 2 * MiB;
constexpr size_t WS_IG = 3 * MiB, WS_LF = 3 * MiB + 512 * 1024;
constexpr size_t WS_NS = 4 * MiB;
constexpr size_t WS_MS = 5 * MiB;
constexpr size_t WS_LNP = 6 * MiB;
constexpr size_t WS_WG = 10 * MiB;
constexpr size_t WS_WM = 10 * MiB + 512 * 1024;
constexpr size_t WS_W = 12 * MiB;
constexpr size_t W_AIN = 0, W_AOUT = 12 * MiB, W_BIN = 16 * MiB, W_BOUT = 24 * MiB, W_CIN = 26 * MiB, W_COUT = 34 * MiB, W_GU = 38 * MiB, W_DN = 82 * MiB;
constexpr size_t SZ_AIN = 6 * MiB, SZ_AOUT = 2 * MiB, SZ_GU = 11 * MiB, SZ_DN = (size_t)1024 * 2816 * 2;
constexpr size_t WS_XB = 116 * MiB;
constexpr size_t WS_S1 = 148 * MiB, WS_S2 = 180 * MiB;
constexpr size_t WS_PROJ = 212 * MiB;
constexpr size_t WS_END = 340 * MiB;
constexpr int LDSCTL_OFF = 131072;
constexpr int CW_BAR = 4096;
constexpr size_t CTL_ZERO_BYTES = 64 * 1024;
constexpr int LDS_BYTES = 147456;

#define LAS __attribute__((address_space(3)))
typedef unsigned short bf16;
typedef float f32x4 __attribute__((ext_vector_type(4)));
typedef float f32x2 __attribute__((ext_vector_type(2)));
typedef float f32x16 __attribute__((ext_vector_type(16)));
typedef short bf16x8 __attribute__((ext_vector_type(8)));
typedef unsigned u32x4 __attribute__((ext_vector_type(4)));
typedef unsigned u32x2 __attribute__((ext_vector_type(2)));
typedef LAS unsigned char* ldsp;
__device__ __forceinline__ unsigned pk2(float lo, float hi) { return pg8::pkbf(lo, hi); }
__device__ __forceinline__ float bf2f(unsigned short h) { return __uint_as_float((unsigned)h << 16); }
__device__ __forceinline__ float bflo(unsigned w) { return __uint_as_float(w << 16); }
__device__ __forceinline__ float bfhi(unsigned w) { return __uint_as_float(w & 0xffff0000u); }
__device__ __forceinline__ float wave_sum(float v) {
#pragma unroll
    for (int o = 1; o < 64; o <<= 1) v += __shfl_xor(v, o);
    return v;
}
__device__ __forceinline__ float log_sigmoid(float x) { return fminf(x, 0.f) - log1pf(expf(-fabsf(x))); }
__device__ __forceinline__ float sigmoid_f(float x) { return __builtin_amdgcn_rcpf(1.0f + __builtin_amdgcn_exp2f(-LOG2E * x)); }
__device__ __forceinline__ float exp_f(float x) { return __builtin_amdgcn_exp2f(LOG2E * x); }
#define LDS_BARRIER() asm volatile("s_waitcnt lgkmcnt(0)\n\ts_barrier" ::: "memory")
#define MFMA32(a, b, c) __builtin_amdgcn_mfma_f32_32x32x16_bf16(a, b, c, 0, 0, 0)

#define XB_TMO      128
#define XB_XCNT(j)  (256  + 64 * (j))
#define XB_XSUB(j)  (1280 + 64 * (j))
#define XB_XGEN(j)  (2304 + 64 * (j))
#define XB_TOP      3328
#define XB_TOPGEN   3392
#define XCD_BAR_WORDS 3456
#define XB_SPIN_CAP (1u << 18)

__device__ __forceinline__ unsigned xb_ld(unsigned* p)              { return __hip_atomic_load(p, __ATOMIC_RELAXED, __HIP_MEMORY_SCOPE_AGENT); }
__device__ __forceinline__ unsigned xb_add(unsigned* p, unsigned v) { return __hip_atomic_fetch_add(p, v, __ATOMIC_RELAXED, __HIP_MEMORY_SCOPE_AGENT); }
__device__ __forceinline__ unsigned xb_xcc_id() { return (unsigned)__builtin_amdgcn_s_getreg((3 << 11) | 20) & 0xFu; }
#define XB_SPIN(cond, bar) do { unsigned _sp = 0; while (cond) { __builtin_amdgcn_s_sleep(1); \
    if ((++_sp & 255u) == 0u) { if (xb_ld(&(bar)[XB_TMO])) break; if (_sp > XB_SPIN_CAP) { atomicAdd(&(bar)[XB_TMO], 1u); break; } } } } while (0)

struct XcdBarrier {
    unsigned* bar; unsigned x;
    volatile LAS unsigned* st;
};

__device__ __forceinline__ XcdBarrier xcd_barrier_post(unsigned* bar, volatile LAS unsigned* st, int tid) {
    XcdBarrier b; b.bar = bar; b.x = xb_xcc_id(); b.st = st;
    if (tid == 0) (void)xb_add(&bar[XB_XCNT(b.x)], 1u);
    return b;
}
__device__ __forceinline__ void xcd_barrier_complete(unsigned* bar, unsigned x, unsigned& nloc, unsigned& nx) {
    const unsigned G = gridDim.x * gridDim.y * gridDim.z;
    unsigned sum, cnt, mine, sp = 0u;
    for (;;) {
        sum = 0u; cnt = 0u; mine = 0u;
#pragma unroll
        for (unsigned j = 0; j < 16; ++j) { const unsigned c = xb_ld(&bar[XB_XCNT(j)]); sum += c; cnt += (c > 0u) ? 1u : 0u; mine = (j == x) ? c : mine; }
        if (sum == G) break;
        __builtin_amdgcn_s_sleep(1);
        if ((++sp & 255u) == 0u) { if (xb_ld(&bar[XB_TMO])) break; if (sp > XB_SPIN_CAP) { atomicAdd(&bar[XB_TMO], 1u); break; } }
    }
    nloc = mine > 0u ? mine : 1u; nx = cnt > 0u ? cnt : 1u;
}

__device__ __forceinline__ void xcd_barrier(const XcdBarrier& b, int tid) {
    asm volatile("s_waitcnt vmcnt(0)" ::: "memory");
    __syncthreads();
    if (tid == 0) {
        unsigned* bar = b.bar;
        __builtin_amdgcn_s_waitcnt(0);
        unsigned nloc = b.st[0], nx = b.st[1];
        if (nloc == 0u) { xcd_barrier_complete(bar, b.x, nloc, nx); b.st[0] = nloc; b.st[1] = nx; }
        const unsigned old = xb_add(&bar[XB_XSUB(b.x)], 1u);
        const unsigned gen = old / nloc;
        if (old + 1u == (gen + 1u) * nloc) {
            __builtin_amdgcn_fence(__ATOMIC_RELEASE, "agent");
            asm volatile("s_waitcnt vmcnt(0)" ::: "memory");
            const unsigned og = xb_add(&bar[XB_TOP], 1u);
            const unsigned tg = og / nx;
            if (og + 1u == (tg + 1u) * nx) xb_add(&bar[XB_TOPGEN], 1u);
            else XB_SPIN(xb_ld(&bar[XB_TOPGEN]) == tg, bar);
            __builtin_amdgcn_fence(__ATOMIC_ACQUIRE, "agent");
            xb_add(&bar[XB_XGEN(b.x)], 1u);
            asm volatile("s_waitcnt vmcnt(0)" ::: "memory");
        } else {
            XB_SPIN(xb_ld(&bar[XB_XGEN(b.x)]) == gen, bar);
            __builtin_amdgcn_fence(__ATOMIC_ACQUIRE, "agent");
            asm volatile("s_waitcnt vmcnt(0)" ::: "memory");
        }
    }
    __syncthreads();
}

struct Frame {
    ldsp lds; int tid, lane, wave, vcu, G;
    const float* const* inp; float* out; unsigned char* ws;
    __device__ __forceinline__ const float* in_(int i) const { asm volatile("" : "+s"(i)); return inp[i]; }
};

struct P0Job { const float* W; const float* gain; bf16* WT; int ldw, K, n0, dst, kb; };
__device__ __forceinline__ void p0_set(P0Job& j, const float* W, int ldw, int K, int N, bf16* WT, const float* gain, int r, bool gu) {
    const int nblk = N / 32, kb = r / nblk, nb = r % nblk; const int n0 = 32 * nb; int dst = n0;
    if (gu) { if (n0 < DFF) dst = 256 * (n0 / 128) + (n0 % 128); else { const int n1 = n0 - DFF; dst = 256 * (n1 / 128) + 128 + (n1 % 128); } }
    j.W = W; j.gain = gain; j.WT = WT; j.ldw = ldw; j.K = K; j.n0 = n0; j.dst = dst; j.kb = kb;
}
constexpr int P0_I_AIN = 16 * 96, P0_I_SQ = 16 * 32, P0_I_BIN = 16 * 128, P0_I_COUT = 32 * 32, P0_I_GU = 16 * 176, P0_I_DN = 44 * 32;
constexpr int P0_MIX = 2 * P0_I_AIN + 2 * P0_I_SQ + P0_I_BIN + P0_I_SQ + P0_I_BIN + P0_I_COUT, P0_FFN = P0_I_GU + P0_I_DN;
__device__ __forceinline__ void p0_decode(Frame& F, int it, P0Job& j, int mode, bool all_ffn) {
    bf16* WB = (bf16*)(F.ws + WS_W); const float* n1g = F.in_(1); const float* n2g = F.in_(2);
    constexpr int I_AIN = P0_I_AIN, I_SQ = P0_I_SQ, I_BIN = P0_I_BIN, I_GU = P0_I_GU, I_DN = P0_I_DN;
    int r = it;
    if (mode > 0) { const int i = mode;
        if (r < I_GU) { p0_set(j, F.in_(20) + (size_t)i * D * 2 * DFF, 2 * DFF, D, 2 * DFF, (bf16*)((char*)WB + W_GU + i * SZ_GU), n2g + i * D, r, true); return; } r -= I_GU;
        p0_set(j, F.in_(21) + (size_t)i * DFF * D, D, DFF, D, (bf16*)((char*)WB + W_DN + i * SZ_DN), nullptr, r, false); return; }
    const int nf = all_ffn ? 4 : 1;
    if (r < nf * I_GU) { const int i = r / I_GU; p0_set(j, F.in_(20) + (size_t)i * D * 2 * DFF, 2 * DFF, D, 2 * DFF, (bf16*)((char*)WB + W_GU + i * SZ_GU), n2g + i * D, r % I_GU, true); return; } r -= nf * I_GU;
    if (r < nf * I_DN) { const int i = r / I_DN; p0_set(j, F.in_(21) + (size_t)i * DFF * D, D, DFF, D, (bf16*)((char*)WB + W_DN + i * SZ_DN), nullptr, r % I_DN, false); return; } r -= nf * I_DN;
    if (r < 2 * I_AIN) { const int i = r / I_AIN; p0_set(j, F.in_(4) + (size_t)i * D * 3088, 3088, D, 3072, (bf16*)((char*)WB + W_AIN + i * SZ_AIN), n1g + (3 * i) * D, r % I_AIN, false); return; } r -= 2 * I_AIN;
    if (r < 2 * I_SQ) { const int i = r / I_SQ; p0_set(j, F.in_(6) + (size_t)i * D * D, D, D, D, (bf16*)((char*)WB + W_AOUT + i * SZ_AOUT), nullptr, r % I_SQ, false); return; } r -= 2 * I_SQ;
    if (r < I_BIN) { p0_set(j, F.in_(7), 4112, D, 4096, (bf16*)((char*)WB + W_BIN), n1g + 1 * D, r, false); return; } r -= I_BIN;
    if (r < I_SQ) { p0_set(j, F.in_(13), D, D, D, (bf16*)((char*)WB + W_BOUT), nullptr, r, false); return; } r -= I_SQ;
    if (r < I_BIN) { p0_set(j, F.in_(14), 4096, D, 4096, (bf16*)((char*)WB + W_CIN), n1g + 2 * D, r, false); return; } r -= I_BIN;
    p0_set(j, F.in_(19), D, 2048, D, (bf16*)((char*)WB + W_COUT), nullptr, r, false);
}
__device__ __forceinline__ void p0_load(const P0Job& j, int lane, f32x4 (&w)[8]) {
    const int kr = lane >> 3, n4 = (lane & 7) * 4;
#pragma unroll
    for (int i = 0; i < 8; ++i) w[i] = __builtin_nontemporal_load((const f32x4*)(j.W + (size_t)(64 * j.kb + 8 * i + kr) * j.ldw + j.n0 + n4));
}
__device__ __forceinline__ void p0_finish(const P0Job& j, int lane, const f32x4 (&w)[8], LAS float* scr) {
    const int k0 = 64 * j.kb, kr = lane >> 3, n4 = (lane & 7) * 4;
#pragma unroll
    for (int i = 0; i < 8; ++i) { const float gk = j.gain ? j.gain[k0 + 8 * i + kr] : 1.0f; LAS float* sp = scr + (8 * i + kr) * 33 + n4; sp[0] = w[i][0] * gk; sp[1] = w[i][1] * gk; sp[2] = w[i][2] * gk; sp[3] = w[i][3] * gk; }
    asm volatile("s_waitcnt lgkmcnt(0)" ::: "memory");
    const int c = lane & 7;
#pragma unroll
    for (int jj = 0; jj < 4; ++jj) { const int n = (lane >> 3) + 8 * jj; const LAS float* s = scr + (8 * c) * 33 + n;
        u32x4 o; o.x = pk2(s[0 * 33], s[1 * 33]); o.y = pk2(s[2 * 33], s[3 * 33]); o.z = pk2(s[4 * 33], s[5 * 33]); o.w = pk2(s[6 * 33], s[7 * 33]);
        pg8::st16(j.WT + (size_t)(j.dst + n) * j.K + k0 + 8 * c, o); }
    asm volatile("s_waitcnt lgkmcnt(0)" ::: "memory");
}
__device__ __forceinline__ void p0_convert(Frame& F, int mode, bool all_ffn, int gw, int NGW, int nitems) {
    LAS float* scr = (LAS float*)(F.lds + F.wave * 16384); const int lane = F.lane;
    if (gw < nitems) {
        int it = gw; P0Job j0; f32x4 w0[8]; p0_decode(F, it, j0, mode, all_ffn); p0_load(j0, lane, w0);
        for (;;) { const int nx = it + NGW; const bool has = nx < nitems; P0Job j1 = j0; f32x4 w1[8];
            if (has) { p0_decode(F, nx, j1, mode, all_ffn); p0_load(j1, lane, w1); }
            p0_finish(j0, lane, w0, scr);
            if (!has) break;
            j0 = j1; it = nx;
#pragma unroll
            for (int i = 0; i < 8; ++i) w0[i] = w1[i]; }
    }
}
__device__ __forceinline__ void p0_prologue(Frame& F) {
    const int gw = F.vcu * NWAVES + F.wave, NGW = F.G * NWAVES, lane = F.lane;
    const float* n1g = F.in_(1);
    const bool all_ffn = (F.G != 256);
    p0_convert(F, -1, all_ffn, gw, NGW, P0_MIX + (all_ffn ? 4 : 1) * P0_FFN);
    { bf16* WG = (bf16*)(F.ws + WS_WG); const int gt = blockIdx.x * (NWAVES * 64) + F.tid, NT = F.G * NWAVES * 64;
      for (int e = gt; e < 3 * 16 * 1024; e += NT) { const int g = e / 16384, n = (e >> 10) & 15, k = e & 1023;
          const float* W = (g < 2) ? F.in_(4) + (size_t)g * D * 3088 : F.in_(7); const int ldw = (g < 2) ? 3088 : 4112, c0 = (g < 2) ? 3072 : 4096;
          const float gn = n1g[((g < 2) ? 3 * g : 1) * D + k];
          WG[e] = (bf16)(pk2(W[(size_t)k * ldw + c0 + n] * gn, 0.f) & 0xffffu); }
      bf16* WM = (bf16*)(F.ws + WS_WM);
      for (int e = gt; e < 8 * 128 * 128; e += NT) { const int t = (e >> 7) & 127, s = e & 127; WM[e] = (bf16)(((t >> 6) >= (s >> 6)) ? (pk2(F.in_(17)[e], 0.f) & 0xffffu) : 0u); } }
    { float* ssq = (float*)(F.ws + WS_SSQ); bf16* XB = (bf16*)(F.ws + WS_XB);
      for (int m = gw; m < M; m += NGW) {
          const f32x4* xr = (const f32x4*)(F.in_(0) + (size_t)m * D) + lane;
          unsigned long long* o8 = (unsigned long long*)(XB + (size_t)m * D) + lane; float s = 0.f;
#pragma unroll
          for (int j = 0; j < 4; ++j) { const f32x4 v = __builtin_nontemporal_load(xr + 64 * j); const unsigned w0 = pk2(v[0], v[1]), w1 = pk2(v[2], v[3]);
              s += (bflo(w0) * bflo(w0) + bfhi(w0) * bfhi(w0)) + (bflo(w1) * bflo(w1) + bfhi(w1) * bfhi(w1));
              o8[64 * j] = (unsigned long long)w0 | ((unsigned long long)w1 << 32); }
          s = wave_sum(s);
          if (lane < 16) ssq[(size_t)m * 16 + lane] = (lane == 0) ? s : 0.f; } }
}


constexpr int RS_OFF = LDSCTL_OFF + 1024;
__device__ __forceinline__ void fill_rstd(Frame& F, const pg8::StaticOrder& S, const float* ssq) {
    LAS float* RS = (LAS float*)(F.lds + RS_OFF); pg8::Unit u;
    for (int i = 0; S.next(i, u); ++i) if (F.tid < 256) { const f32x4* sp = (const f32x4*)(ssq + (size_t)(u.pm * 256 + F.tid) * 16); const f32x4 s0 = sp[0], s1 = sp[1], s2 = sp[2], s3 = sp[3];
        const float ss = ((s0[0] + s0[1]) + (s0[2] + s0[3])) + ((s1[0] + s1[1]) + (s1[2] + s1[3])) + ((s2[0] + s2[1]) + (s2[2] + s2[3])) + ((s3[0] + s3[1]) + (s3[2] + s3[3]));
        RS[i * 256 + F.tid] = 1.0f / sqrtf(ss * (1.0f / 1024.0f) + EPS); }
    __syncthreads();
}

struct RstdPre {
    const pg8::StaticOrder* S; const float* ssq; LAS float* RS; f32x4 v[3][4]; int nu;
    __device__ __forceinline__ void issue(int tid) { pg8::Unit u; nu = 0;
#pragma unroll
        for (int k = 0; k < 3; ++k) { const int i = 2 * k + (tid >> 8); if (S->next(i, u)) { const f32x4* sp = (const f32x4*)(ssq + (size_t)(u.pm * 256 + (tid & 255)) * 16); v[k][0] = sp[0]; v[k][1] = sp[1]; v[k][2] = sp[2]; v[k][3] = sp[3]; nu = k + 1; } } }
    __device__ __forceinline__ void finish(int tid) {
#pragma unroll
        for (int k = 0; k < 3; ++k) if (k < nu) { const f32x4 s0 = v[k][0], s1 = v[k][1], s2 = v[k][2], s3 = v[k][3];
            const float ss = ((s0[0] + s0[1]) + (s0[2] + s0[3])) + ((s1[0] + s1[1]) + (s1[2] + s1[3])) + ((s2[0] + s2[1]) + (s2[2] + s2[3])) + ((s3[0] + s3[1]) + (s3[2] + s3[3]));
            RS[(2 * k + (tid >> 8)) * 256 + (tid & 255)] = 1.0f / sqrtf(ss * (1.0f / 1024.0f) + EPS); } }
};
template <int KIND>
__device__ __forceinline__ void gate_items(Frame& F, const bf16* XB, const bf16* WG, const float* ssq, const float* bias0, const float* bias1, float* out0, float* out1) {
    const int lane = F.lane, wq = F.wave & 3, kh = F.wave >> 2; LAS f32x4* XS = (LAS f32x4*)F.lds;
    for (int it0 = 0; it0 < M / 16; it0 += 4 * F.G) {
        const int it = it0 + wq * F.G + F.vcu; const bool live = it < M / 16; const int row0 = (live ? it : 0) * 16;
        const bf16* ap = XB + (size_t)(row0 + (lane & 15)) * D + kh * 512 + (lane >> 4) * 8; const bf16* bp = WG + (size_t)(lane & 15) * D + kh * 512 + (lane >> 4) * 8;
        f32x4 acc = {0.f, 0.f, 0.f, 0.f};
#pragma unroll
        for (int ks = 0; ks < 16; ++ks) { const bf16x8 a = *(const bf16x8*)(ap + ks * 32), b = *(const bf16x8*)(bp + ks * 32); acc = __builtin_amdgcn_mfma_f32_16x16x32_bf16(a, b, acc, 0, 0, 0); }
        if (kh == 1) XS[wq * 64 + lane] = acc;
        __syncthreads();
        if (kh == 0 && live) {
            acc += XS[wq * 64 + lane];
            const int g = lane & 15, t0 = row0 + (lane >> 4) * 4, b = t0 / SEQ, s = t0 % SEQ;
            f32x4 val;
#pragma unroll
            for (int r = 0; r < 4; ++r) { const f32x4* sp = (const f32x4*)(ssq + (size_t)(t0 + r) * 16); const f32x4 s0 = sp[0], s1 = sp[1], s2 = sp[2], s3 = sp[3];
                const float ss = ((s0[0] + s0[1]) + (s0[2] + s0[3])) + ((s1[0] + s1[1]) + (s1[2] + s1[3])) + ((s2[0] + s2[1]) + (s2[2] + s2[3])) + ((s3[0] + s3[1]) + (s3[2] + s3[3]));
                const float f = acc[r] * (1.0f / sqrtf(ss * (1.0f / 1024.0f) + EPS));
                if (KIND == 0) val[r] = LOG2E * log_sigmoid(f + bias0[g]);
                else val[r] = (g < 8) ? f + bias0[g] : log_sigmoid(f + bias1[g - 8]); }
            if (KIND == 0) *(f32x4*)(out0 + (size_t)(b * 16 + g) * SEQ + s) = val;
            else { if (g < 8) *(f32x4*)(out0 + (size_t)(b * 8 + g) * SEQ + s) = val; else *(f32x4*)(out1 + (size_t)(b * 8 + g - 8) * SEQ + s) = val; }
        }
        __syncthreads();
    }
}

typedef short s16x4 __attribute__((ext_vector_type(4)));
__device__ __forceinline__ s16x4 tr16(const LAS unsigned char* p) { return __builtin_bit_cast(s16x4, __builtin_amdgcn_ds_read_tr16_b64_v4i16((LAS s16x4*)p)); }
__device__ __forceinline__ bf16x8 tr_frag(const LAS unsigned char* base, int pitch, int lane) {
    const LAS unsigned char* p = base + (8 * (lane >> 5) + ((lane & 15) >> 2)) * pitch + (16 * ((lane >> 4) & 1) + 4 * (lane & 3)) * 2;
    const s16x4 lo = tr16(p), hi = tr16(p + 4 * pitch); return (bf16x8){lo[0], lo[1], lo[2], lo[3], hi[0], hi[1], hi[2], hi[3]};
}
__device__ __forceinline__ void conv_silu8(const bf16* proj, int b, int t, int col, const float* cw, const float* cb, float scale, float (&o)[8]) {
    const f32x4 b0 = *(const f32x4*)(cb + col), b1 = *(const f32x4*)(cb + col + 4);
    float a[8] = {b0[0], b0[1], b0[2], b0[3], b1[0], b1[1], b1[2], b1[3]};
#pragma unroll
    for (int j = 0; j < 4; ++j) { const int tt = t - 3 + j;
        if (tt >= 0) { const u32x4 x = *(const u32x4*)(proj + (size_t)(b * SEQ + tt) * 4096 + col); const f32x4 w0 = *(const f32x4*)(cw + j * 2048 + col), w1 = *(const f32x4*)(cw + j * 2048 + col + 4);
            a[0] += w0[0] * bflo(x.x); a[1] += w0[1] * bfhi(x.x); a[2] += w0[2] * bflo(x.y); a[3] += w0[3] * bfhi(x.y);
            a[4] += w1[0] * bflo(x.z); a[5] += w1[1] * bfhi(x.z); a[6] += w1[2] * bflo(x.w); a[7] += w1[3] * bfhi(x.w); } }
#pragma unroll
    for (int i = 0; i < 8; ++i) o[i] = a[i] * __builtin_amdgcn_rcpf(1.0f + __builtin_amdgcn_exp2f(-LOG2E * a[i])) * scale;
}
template <int CTRL> __device__ __forceinline__ float dpp_mov(float v) { return __builtin_bit_cast(float, __builtin_amdgcn_update_dpp(0, __builtin_bit_cast(int, v), CTRL, 0xf, 0xf, false)); }
__device__ __forceinline__ float wave_scan_add(float v, int lane) {
    const int rl = lane & 15; float t;
    t = dpp_mov<0x111>(v); v = (rl >= 1) ? v + t : v;
    t = dpp_mov<0x112>(v); v = (rl >= 2) ? v + t : v;
    t = dpp_mov<0x114>(v); v = (rl >= 4) ? v + t : v;
    t = dpp_mov<0x118>(v); v = (rl >= 8) ? v + t : v;
    t = dpp_mov<0x142>(v); v = ((lane & 31) >= 16) ? v + t : v;
    t = dpp_mov<0x143>(v); v = (lane >= 32) ? v + t : v;
    return v;
}
__device__ __forceinline__ float wave_scan_max(float v, int lane) {
    const int rl = lane & 15; float t;
    t = dpp_mov<0x111>(v); v = (rl >= 1) ? fmaxf(v, t) : v;
    t = dpp_mov<0x112>(v); v = (rl >= 2) ? fmaxf(v, t) : v;
    t = dpp_mov<0x114>(v); v = (rl >= 4) ? fmaxf(v, t) : v;
    t = dpp_mov<0x118>(v); v = (rl >= 8) ? fmaxf(v, t) : v;
    t = dpp_mov<0x142>(v); v = ((lane & 31) >= 16) ? fmaxf(v, t) : v;
    t = dpp_mov<0x143>(v); v = (lane >= 32) ? fmaxf(v, t) : v;
    return v;
}
__device__ __forceinline__ float lane63(float v) { return __builtin_bit_cast(float, __builtin_amdgcn_readlane(__builtin_bit_cast(int, v), 63)); }
__device__ __forceinline__ float wave_max(float v, int lane) { return lane63(wave_scan_max(v, lane)); }
constexpr int PA_KS = 0, PA_KSB = 64 * 40 * 2, PA_VS = 2 * PA_KSB, PA_VSB = 64 * 136 * 2;
__device__ __forceinline__ void mlstm_pass_a(Frame& F, const bf16* proj, const float* IG, const float* LF, const float* cw, const float* cb, bf16* CST, float* NS, float* MS) {
    const int tid = F.tid, lane = F.lane, wave = F.wave, r32 = lane & 31, hh = lane >> 5;
    for (int u = F.vcu; u < 256; u += F.G) {
        const int bh = u >> 2, ds = u & 3, b = bh >> 3, h = bh & 7;
        const int dg = tid & 3, sk = (tid >> 2) & 63, colk = 1024 + h * 128 + ds * 32 + dg * 8;
        const int eg = tid & 15, s0 = tid >> 4, colv = 2048 + h * 128 + eg * 8;
        float wt[4][8], bs8[8];
        { const f32x4 b0 = *(const f32x4*)(cb + colk), b1 = *(const f32x4*)(cb + colk + 4);
#pragma unroll
          for (int i = 0; i < 4; ++i) { bs8[i] = b0[i]; bs8[4 + i] = b1[i]; }
#pragma unroll
          for (int j = 0; j < 4; ++j) { const f32x4 w0 = *(const f32x4*)(cw + j * 2048 + colk), w1 = *(const f32x4*)(cw + j * 2048 + colk + 4);
#pragma unroll
              for (int i = 0; i < 4; ++i) { wt[j][i] = w0[i]; wt[j][4 + i] = w1[i]; } } }
        const bf16* pk = proj + (size_t)(b * SEQ) * 4096 + colk; const bf16* pv = proj + (size_t)(b * SEQ) * 4096 + colv;
        u32x4 rkA[4], rkB[4], rvA[2], rvB[2];
#define PA_LOAD_RAW(rk, rv, c_) do { if (tid < 256) { _Pragma("unroll") for (int j_ = 0; j_ < 4; ++j_) { const int tt_ = 64 * (c_) + sk - 3 + j_; \
            rk[j_] = (tt_ >= 0) ? *(const u32x4*)(pk + (size_t)tt_ * 4096) : (u32x4){0u, 0u, 0u, 0u}; } } \
            _Pragma("unroll") for (int i_ = 0; i_ < 2; ++i_) rv[i_] = *(const u32x4*)(pv + (size_t)(64 * (c_) + s0 + 32 * i_) * 4096); } while (0)
#pragma unroll
        for (int j = 0; j < 4; ++j) { rkA[j] = (u32x4){0u, 0u, 0u, 0u}; rkB[j] = (u32x4){0u, 0u, 0u, 0u}; }
        PA_LOAD_RAW(rkA, rvA, 0);
        float lfn = LF[(size_t)bh * SEQ + lane], ign = IG[(size_t)bh * SEQ + lane];
        f32x16 acc = {}; float mprev = 0.f;
        const bf16x8 ones = (bf16x8){0x3F80, 0x3F80, 0x3F80, 0x3F80, 0x3F80, 0x3F80, 0x3F80, 0x3F80};
#define PA_CHUNK(c, rkc, rvc, rkn, rvn) do { \
            const int buf = c & 1; \
            if (c + 1 < 32) PA_LOAD_RAW(rkn, rvn, c + 1); \
            const float lf = lfn, ig = ign; \
            if (c + 1 < 32) { lfn = LF[(size_t)bh * SEQ + 64 * (c + 1) + lane]; ign = IG[(size_t)bh * SEQ + 64 * (c + 1) + lane]; } \
            const float bcum = wave_scan_add(lf, lane), bL = lane63(bcum); \
            const float g = bL - bcum + ig, gmax = wave_max(g, lane), mnew = fmaxf(bL + mprev, gmax); \
            const float w = exp_f(g - mnew), decay = exp_f(bL + mprev - mnew); \
            if (wave < 4) { bf16* cp = CST + (((size_t)(bh * 32 + c) * 128 + 32 * wave + r32) * 128) + 32 * ds + 4 * hh; \
                _Pragma("unroll") for (int q = 0; q < 4; ++q) { u32x2 pk_; pk_.x = pk2(acc[4 * q], acc[4 * q + 1]); pk_.y = pk2(acc[4 * q + 2], acc[4 * q + 3]); *(u32x2*)(cp + 8 * q) = pk_; } } \
            else if (wave == 4 && r32 == 0) { float* np = NS + (size_t)(bh * 32 + c) * 128 + 32 * ds + 4 * hh; \
                _Pragma("unroll") for (int q = 0; q < 4; ++q) *(f32x4*)(np + 8 * q) = (f32x4){acc[4 * q], acc[4 * q + 1], acc[4 * q + 2], acc[4 * q + 3]}; } \
            if (tid == 0 && ds == 0) MS[bh * 32 + c] = mprev; \
            if (tid < 256) { float a[8]; \
                _Pragma("unroll") for (int ch = 0; ch < 8; ++ch) a[ch] = bs8[ch]; \
                _Pragma("unroll") for (int j = 0; j < 4; ++j) { const u32x4 x = rkc[j]; \
                    a[0] += wt[j][0] * bflo(x.x); a[1] += wt[j][1] * bfhi(x.x); a[2] += wt[j][2] * bflo(x.y); a[3] += wt[j][3] * bfhi(x.y); \
                    a[4] += wt[j][4] * bflo(x.z); a[5] += wt[j][5] * bfhi(x.z); a[6] += wt[j][6] * bflo(x.w); a[7] += wt[j][7] * bfhi(x.w); } \
                const float ws = __shfl(w, sk) * 0.08838834764831845f; \
                _Pragma("unroll") for (int ch = 0; ch < 8; ++ch) a[ch] = a[ch] * __builtin_amdgcn_rcpf(1.0f + __builtin_amdgcn_exp2f(-LOG2E * a[ch])) * ws; \
                u32x4 o; o.x = pk2(a[0], a[1]); o.y = pk2(a[2], a[3]); o.z = pk2(a[4], a[5]); o.w = pk2(a[6], a[7]); \
                *(LAS u32x4*)(F.lds + PA_KS + buf * PA_KSB + (sk * 40 + dg * 8) * 2) = o; } \
            _Pragma("unroll") for (int i = 0; i < 2; ++i) *(LAS u32x4*)(F.lds + PA_VS + buf * PA_VSB + ((s0 + 32 * i) * 136 + eg * 8) * 2) = rvc[i]; \
            LDS_BARRIER(); \
            _Pragma("unroll") for (int r = 0; r < 16; ++r) acc[r] *= decay; \
            if (wave < 4) { \
                _Pragma("unroll") for (int ks = 0; ks < 4; ++ks) { const bf16x8 a = tr_frag(F.lds + PA_KS + buf * PA_KSB + (16 * ks * 40) * 2, 80, lane); \
                    const bf16x8 bb = tr_frag(F.lds + PA_VS + buf * PA_VSB + (16 * ks * 136 + 32 * wave) * 2, 272, lane); acc = MFMA32(a, bb, acc); } \
            } else if (wave == 4) { \
                _Pragma("unroll") for (int ks = 0; ks < 4; ++ks) { const bf16x8 a = tr_frag(F.lds + PA_KS + buf * PA_KSB + (16 * ks * 40) * 2, 80, lane); acc = MFMA32(a, ones, acc); } \
            } \
            mprev = mnew; \
        } while (0)
        for (int c2 = 0; c2 < 32; c2 += 2) { PA_CHUNK(c2, rkA, rvA, rkB, rvB); PA_CHUNK((c2 + 1), rkB, rvB, rkA, rvA); }
#undef PA_CHUNK
#undef PA_LOAD_RAW
        LDS_BARRIER();
    }
}
constexpr int PB_QS = 0, PB_KS = 17408, PB_VT = 34816, PB_SQK = 53248, PB_HF = 62464, PB_NV = 96256, PB_MR = 96768, PB_AR = 97024, PB_EM = 97280, PB_CW = 97536, PB_CB = PB_CW + 4096, PB_NG = PB_CB + 1024;
__device__ __forceinline__ void conv8_regs(const u32x4& r0, const u32x4& r1, const u32x4& r2, const u32x4& r3, const LAS float* CW, const LAS float* CB, int m, int dg, float scale, u32x4& o) {
    const u32x4 r[4] = {r0, r1, r2, r3};
    const f32x4 b0 = *(const LAS f32x4*)(CB + m * 128 + dg * 8), b1 = *(const LAS f32x4*)(CB + m * 128 + dg * 8 + 4);
    float a[8] = {b0[0], b0[1], b0[2], b0[3], b1[0], b1[1], b1[2], b1[3]};
#pragma unroll
    for (int j = 0; j < 4; ++j) { const f32x4 w0 = *(const LAS f32x4*)(CW + (m * 4 + j) * 128 + dg * 8), w1 = *(const LAS f32x4*)(CW + (m * 4 + j) * 128 + dg * 8 + 4); const u32x4 x = r[j];
        a[0] += w0[0] * bflo(x.x); a[1] += w0[1] * bfhi(x.x); a[2] += w0[2] * bflo(x.y); a[3] += w0[3] * bfhi(x.y);
        a[4] += w1[0] * bflo(x.z); a[5] += w1[1] * bfhi(x.z); a[6] += w1[2] * bflo(x.w); a[7] += w1[3] * bfhi(x.w); }
#pragma unroll
    for (int i = 0; i < 8; ++i) a[i] = a[i] * __builtin_amdgcn_rcpf(1.0f + __builtin_amdgcn_exp2f(-LOG2E * a[i])) * scale;
    o.x = pk2(a[0], a[1]); o.y = pk2(a[2], a[3]); o.z = pk2(a[4], a[5]); o.w = pk2(a[6], a[7]);
}
__device__ __forceinline__ void mlstm_pass_b(Frame& F, const bf16* proj, const float* IG, const float* LF, const float* cw, const float* cb, const bf16* CST, const float* NS, const float* MS, const float* ng, bf16* Y) {
    const int tid = F.tid, lane = F.lane, wave = F.wave, r32 = lane & 31, hh = lane >> 5;
    LAS float* MR = (LAS float*)(F.lds + PB_MR); LAS float* AR = (LAS float*)(F.lds + PB_AR); LAS float* EM = (LAS float*)(F.lds + PB_EM); LAS float* NV = (LAS float*)(F.lds + PB_NV);
    LAS float* CW = (LAS float*)(F.lds + PB_CW); LAS float* CB = (LAS float*)(F.lds + PB_CB);
    const int dg = tid & 15, s0 = tid >> 4;
    for (int base = F.vcu * 8; base < 2048; base += F.G * 8) {
        const int bh = base >> 5, b = bh >> 3, h = bh & 7, c0 = base & 31;
        for (int e2 = tid; e2 < 1024; e2 += NWAVES * 64) { const int m = e2 >> 9, j = (e2 >> 7) & 3, ch = e2 & 127; CW[e2] = cw[j * 2048 + m * 1024 + h * 128 + ch]; }
        if (tid < 256) CB[tid] = cb[(tid >> 7) * 1024 + h * 128 + (tid & 127)];
        if (tid >= 256 && tid < 384) ((LAS float*)(F.lds + PB_NG))[tid - 256] = ng[h * 128 + tid - 256];
        LDS_BARRIER();
        const bf16* pq = proj + (size_t)(b * SEQ) * 4096 + h * 128 + dg * 8;
        const int hcol = h * 128 + 16 * (tid & 7);
        u32x4 rq[5], rk[5], rv[2]; float lfn, ign, msn, nvn = 0.f;
#define PB_LOAD_RAW(c_) do { _Pragma("unroll") for (int j_ = 0; j_ < 5; ++j_) { const int tt_ = 64 * (c_) + 2 * s0 - 3 + j_; \
              rq[j_] = (tt_ >= 0) ? *(const u32x4*)(pq + (size_t)tt_ * 4096) : (u32x4){0u, 0u, 0u, 0u}; rk[j_] = (tt_ >= 0) ? *(const u32x4*)(pq + (size_t)tt_ * 4096 + 1024) : (u32x4){0u, 0u, 0u, 0u}; } \
            _Pragma("unroll") for (int i_ = 0; i_ < 2; ++i_) rv[i_] = *(const u32x4*)(pq + (size_t)(64 * (c_) + 2 * s0 + i_) * 4096 + 2048); \
            lfn = LF[(size_t)bh * SEQ + 64 * (c_) + lane]; ign = IG[(size_t)bh * SEQ + 64 * (c_) + lane]; msn = MS[bh * 32 + (c_)]; if (tid < 128) nvn = NS[(size_t)(bh * 32 + (c_)) * 128 + tid]; } while (0)
        PB_LOAD_RAW(c0);
        for (int i8 = 0; i8 < 8; ++i8) {
        const int c = c0 + i8;
        const float lf = lfn, ig = ign, mprev = msn;
        const int ti = wave >> 2, ej = wave & 3;
        bf16x8 cfr[8];
        { const bf16* cp = CST + ((size_t)(bh * 32 + c) * 128 + 32 * ej + r32) * 128 + 8 * hh;
#pragma unroll
          for (int ks = 0; ks < 8; ++ks) cfr[ks] = *(const bf16x8*)(cp + 16 * ks); }
        const float bcum = wave_scan_add(lf, lane), uu = ig - bcum, pm = wave_scan_max(uu, lane), Mt = fmaxf(mprev, pm);
        if (wave == 0) { MR[lane] = Mt; AR[lane] = exp_f(mprev - Mt); EM[lane] = exp_f(-(bcum + Mt)); }
#pragma unroll
        for (int i = 0; i < 2; ++i) { const int s = 2 * s0 + i; u32x4 o;
            conv8_regs(rq[i], rq[i + 1], rq[i + 2], rq[i + 3], CW, CB, 0, dg, 1.0f, o); *(LAS u32x4*)(F.lds + PB_QS + (s * 136 + dg * 8) * 2) = o;
            conv8_regs(rk[i], rk[i + 1], rk[i + 2], rk[i + 3], CW, CB, 1, dg, 0.08838834764831845f, o); *(LAS u32x4*)(F.lds + PB_KS + (s * 136 + dg * 8) * 2) = o;
            *(LAS u32x4*)(F.lds + PB_VT + (s * 136 + dg * 8) * 2) = rv[i]; }
        const size_t hrow = (size_t)(b * SEQ + 64 * c + (tid >> 3));
        const u32x4 og0 = __builtin_nontemporal_load((const u32x4*)(proj + hrow * 4096 + 3072 + hcol)), og1 = __builtin_nontemporal_load((const u32x4*)(proj + hrow * 4096 + 3072 + hcol + 8));
        if (tid < 128) NV[tid] = nvn;
        if (i8 + 1 < 8) PB_LOAD_RAW(c + 1);
        LDS_BARRIER();
        f32x16 acc = {};
        {
#pragma unroll
          for (int ks = 0; ks < 8; ++ks) { const bf16x8 a = *(const LAS bf16x8*)(F.lds + PB_QS + ((32 * ti + r32) * 136 + 16 * ks + 8 * hh) * 2); acc = MFMA32(a, cfr[ks], acc); }
#pragma unroll
          for (int q = 0; q < 4; ++q) { const f32x4 av = *(const LAS f32x4*)(AR + 32 * ti + 8 * q + 4 * hh);
#pragma unroll
              for (int j = 0; j < 4; ++j) acc[4 * q + j] *= av[j]; } }
        if (wave < 3) { const int sti = (wave + 1) >> 1, sj = wave >> 1;
            f32x16 sa = {};
#pragma unroll
            for (int ks = 0; ks < 8; ++ks) { const bf16x8 a = *(const LAS bf16x8*)(F.lds + PB_QS + ((32 * sti + r32) * 136 + 16 * ks + 8 * hh) * 2); const bf16x8 bb = *(const LAS bf16x8*)(F.lds + PB_KS + ((32 * sj + r32) * 136 + 16 * ks + 8 * hh) * 2); sa = MFMA32(a, bb, sa); }
            const int s = 32 * sj + r32; const float us = __shfl(uu, s);
#pragma unroll
            for (int q = 0; q < 4; ++q) { const f32x4 mv = *(const LAS f32x4*)(MR + 32 * sti + 8 * q + 4 * hh);
#pragma unroll
                for (int j = 0; j < 4; ++j) { const int t = 32 * sti + 8 * q + 4 * hh + j; const float val = (s <= t) ? sa[4 * q + j] * exp_f(us - mv[j]) : 0.f;
                    *((LAS bf16*)(F.lds + PB_SQK) + t * 72 + s) = (bf16)(pk2(val, 0.f) & 0xffffu); } }
        } else if (wave == 3) {
#pragma unroll
            for (int r = 0; r < 16; ++r) { const int t = (r & 3) + 8 * (r >> 2) + 4 * hh; *((LAS bf16*)(F.lds + PB_SQK) + t * 72 + 32 + r32) = (bf16)0; } }
        LDS_BARRIER();
#pragma unroll
        for (int ks = 0; ks < 4; ++ks) { const bf16x8 a = *(const LAS bf16x8*)(F.lds + PB_SQK + ((32 * ti + r32) * 72 + 16 * ks + 8 * hh) * 2); const bf16x8 bb = tr_frag(F.lds + PB_VT + (16 * ks * 136 + 32 * ej) * 2, 272, lane); acc = MFMA32(a, bb, acc); }
#pragma unroll
        for (int r = 0; r < 16; ++r) { const int t = 32 * ti + (r & 3) + 8 * (r >> 2) + 4 * hh; *((LAS float*)(F.lds + PB_HF) + t * 132 + 32 * ej + r32) = acc[r]; }
        LDS_BARRIER();
        { const int t = tid >> 3, p = tid & 7; float dq = 0.f, ds = 0.f;
          { const u32x4 q0 = *(const LAS u32x4*)(F.lds + PB_QS + (t * 136 + 16 * p) * 2), q1 = *(const LAS u32x4*)(F.lds + PB_QS + (t * 136 + 16 * p + 8) * 2);
            const LAS f32x4* nv = (const LAS f32x4*)(NV + 16 * p); const f32x4 n0 = nv[0], n1 = nv[1], n2 = nv[2], n3 = nv[3];
            dq = (bflo(q0.x) * n0[0] + bfhi(q0.x) * n0[1]) + (bflo(q0.y) * n0[2] + bfhi(q0.y) * n0[3]) + (bflo(q0.z) * n1[0] + bfhi(q0.z) * n1[1]) + (bflo(q0.w) * n1[2] + bfhi(q0.w) * n1[3])
               + (bflo(q1.x) * n2[0] + bfhi(q1.x) * n2[1]) + (bflo(q1.y) * n2[2] + bfhi(q1.y) * n2[3]) + (bflo(q1.z) * n3[0] + bfhi(q1.z) * n3[1]) + (bflo(q1.w) * n3[2] + bfhi(q1.w) * n3[3]);
            const u32x4 sq = *(const LAS u32x4*)(F.lds + PB_SQK + (t * 72 + 8 * p) * 2);
            ds = ((bflo(sq.x) + bfhi(sq.x)) + (bflo(sq.y) + bfhi(sq.y))) + ((bflo(sq.z) + bfhi(sq.z)) + (bflo(sq.w) + bfhi(sq.w))); }
          float den = AR[t] * dq + ds; den += __shfl_xor(den, 1); den += __shfl_xor(den, 2); den += __shfl_xor(den, 4);
          const float inv = __builtin_amdgcn_rcpf(fmaxf(fabsf(den), EM[t]));
          const LAS f32x4* hp = (const LAS f32x4*)((LAS float*)(F.lds + PB_HF) + t * 132 + 16 * p); float x[16]; float ss = 0.f;
#pragma unroll
          for (int i = 0; i < 4; ++i) { const f32x4 v = hp[i]; x[4 * i] = v[0] * inv; x[4 * i + 1] = v[1] * inv; x[4 * i + 2] = v[2] * inv; x[4 * i + 3] = v[3] * inv; }
#pragma unroll
          for (int i = 0; i < 16; ++i) ss += x[i] * x[i];
          ss += __shfl_xor(ss, 1); ss += __shfl_xor(ss, 2); ss += __shfl_xor(ss, 4);
          const float rn = __builtin_amdgcn_rsqf(ss * (1.0f / 128.0f) + EPS);
          const size_t row = hrow; const int col = hcol;
          const unsigned ow[8] = {og0.x, og0.y, og0.z, og0.w, og1.x, og1.y, og1.z, og1.w};
          const LAS f32x4* gq = (const LAS f32x4*)((LAS float*)(F.lds + PB_NG) + 16 * p); const f32x4 ng0 = gq[0], ng1 = gq[1], ng2 = gq[2], ng3 = gq[3];
          const float gn[16] = {ng0[0], ng0[1], ng0[2], ng0[3], ng1[0], ng1[1], ng1[2], ng1[3], ng2[0], ng2[1], ng2[2], ng2[3], ng3[0], ng3[1], ng3[2], ng3[3]};
          unsigned res[8];
#pragma unroll
          for (int i = 0; i < 8; ++i) res[i] = pk2(x[2 * i] * rn * gn[2 * i] * sigmoid_f(bflo(ow[i])), x[2 * i + 1] * rn * gn[2 * i + 1] * sigmoid_f(bfhi(ow[i])));
          pg8::st16(Y + row * 1024 + col, (u32x4){res[0], res[1], res[2], res[3]}); pg8::st16(Y + row * 1024 + col + 8, (u32x4){res[4], res[5], res[6], res[7]}); }
        LDS_BARRIER();
        }
#undef PB_LOAD_RAW
    }
}

constexpr int SG_VT = 0, SG_WS = 256 * 136 * 2, SG_ST = SG_WS + 128 * 136 * 2;
__device__ __forceinline__ void sgu_phase(Frame& F, const bf16* Z, const float* lnp, const float* lg, const float* lb, const bf16* WM, const float* bs, bf16* OUT) {
    const int tid = F.tid, lane = F.lane, wave = F.wave, r32 = lane & 31, hh = lane >> 5;
    LAS float* ST = (LAS float*)(F.lds + SG_ST);
    for (int u = F.vcu; u < 1024; u += F.G) {
        const int span = u >> 3, g = u & 7; const size_t row0 = (size_t)span * 128;
        { const int r = tid >> 2, p = tid & 3; const f32x4* pp = (const f32x4*)(lnp + ((row0 + r) * 32 + 8 * p) * 2); float s1 = 0.f, s2 = 0.f;
#pragma unroll
          for (int i = 0; i < 4; ++i) { const f32x4 v = pp[i]; s1 += v[0] + v[2]; s2 += v[1] + v[3]; }
          s1 += __shfl_xor(s1, 1); s1 += __shfl_xor(s1, 2); s2 += __shfl_xor(s2, 1); s2 += __shfl_xor(s2, 2);
          const float mu = s1 * (1.0f / 2048.0f), var = fmaxf(s2 * (1.0f / 2048.0f) - mu * mu, 0.f);
          if (p == 0) { ST[2 * r] = mu; ST[2 * r + 1] = 1.0f / sqrtf(var + EPS); } }
#pragma unroll
        for (int i = 0; i < 4; ++i) { const int item = tid + 512 * i, t = item >> 4, sg = item & 15; *(LAS u32x4*)(F.lds + SG_WS + (t * 136 + sg * 8) * 2) = *(const u32x4*)(WM + ((size_t)g * 128 + t) * 128 + sg * 8); }
        __syncthreads();
#pragma unroll
        for (int i = 0; i < 8; ++i) { const int item = tid + 512 * i, s = item >> 5, cg8 = item & 31; const int col = g * 256 + cg8 * 8;
            const u32x4 x = *(const u32x4*)(Z + (row0 + s) * 4096 + 2048 + col); const float mu = ST[2 * s], rs = ST[2 * s + 1];
            const f32x4 g0 = *(const f32x4*)(lg + col), g1 = *(const f32x4*)(lg + col + 4), b0 = *(const f32x4*)(lb + col), b1 = *(const f32x4*)(lb + col + 4);
            LAS bf16* vt = (LAS bf16*)(F.lds + SG_VT) + (cg8 * 8) * 136 + s;
            vt[0 * 136] = (bf16)(pk2((bflo(x.x) - mu) * rs * g0[0] + b0[0], 0.f) & 0xffffu); vt[1 * 136] = (bf16)(pk2((bfhi(x.x) - mu) * rs * g0[1] + b0[1], 0.f) & 0xffffu);
            vt[2 * 136] = (bf16)(pk2((bflo(x.y) - mu) * rs * g0[2] + b0[2], 0.f) & 0xffffu); vt[3 * 136] = (bf16)(pk2((bfhi(x.y) - mu) * rs * g0[3] + b0[3], 0.f) & 0xffffu);
            vt[4 * 136] = (bf16)(pk2((bflo(x.z) - mu) * rs * g1[0] + b1[0], 0.f) & 0xffffu); vt[5 * 136] = (bf16)(pk2((bfhi(x.z) - mu) * rs * g1[1] + b1[1], 0.f) & 0xffffu);
            vt[6 * 136] = (bf16)(pk2((bflo(x.w) - mu) * rs * g1[2] + b1[2], 0.f) & 0xffffu); vt[7 * 136] = (bf16)(pk2((bfhi(x.w) - mu) * rs * g1[3] + b1[3], 0.f) & 0xffffu); }
        __syncthreads();
        f32x16 acc[4] = {};
#pragma unroll
        for (int ks = 0; ks < 8; ++ks) { const bf16x8 bb = *(const LAS bf16x8*)(F.lds + SG_VT + ((32 * wave + r32) * 136 + 16 * ks + 8 * hh) * 2);
#pragma unroll
            for (int ti = 0; ti < 4; ++ti) { const bf16x8 a = *(const LAS bf16x8*)(F.lds + SG_WS + ((32 * ti + r32) * 136 + 16 * ks + 8 * hh) * 2); acc[ti] = MFMA32(a, bb, acc[ti]); } }
        const int col = g * 256 + 32 * wave + r32;
#pragma unroll
        for (int ti = 0; ti < 4; ++ti)
#pragma unroll
            for (int r = 0; r < 16; ++r) { const int t = 32 * ti + (r & 3) + 8 * (r >> 2) + 4 * hh; const float uv = bf2f(Z[(row0 + t) * 4096 + col]);
                OUT[(row0 + t) * 2048 + col] = (bf16)(pk2(uv * (acc[ti][r] + bs[g * 128 + t]), 0.f) & 0xffffu); }
        __syncthreads();
    }
}

constexpr int SG2_VI = 0, SG2_WS = 67584, SG2_ST = SG2_WS + 34816, SG2_BS = SG2_ST + 1024;
__device__ __forceinline__ void sgu_phase2(Frame& F, const bf16* Z, const float* lnp, const float* lg, const float* lb, const bf16* WM, const float* bs, bf16* OUT) {
    const int tid = F.tid, lane = F.lane, wave = F.wave, r32 = lane & 31, hh = lane >> 5;
    LAS float* ST = (LAS float*)(F.lds + SG2_ST); LAS float* BS = (LAS float*)(F.lds + SG2_BS); LAS float* SF = (LAS float*)(F.lds + SG2_VI);
    for (int u = F.vcu; u < 1024; u += F.G) {
        const int span = u >> 3, g = u & 7; const size_t row0 = (size_t)span * 128;
        const int cg8 = tid & 31, colv = g * 256 + cg8 * 8;
        u32x4 xv[8];
#pragma unroll
        for (int i = 0; i < 8; ++i) xv[i] = __builtin_nontemporal_load((const u32x4*)(Z + (row0 + (tid >> 5) + 16 * i) * 4096 + 2048 + colv));
        u32x4 wmv[4];
#pragma unroll
        for (int i = 0; i < 4; ++i) { const int item = tid + 512 * i, t = item >> 4, sg = item & 15; wmv[i] = *(const u32x4*)(WM + ((size_t)g * 128 + t) * 128 + sg * 8); }
        const f32x4 g0 = *(const f32x4*)(lg + colv), g1 = *(const f32x4*)(lg + colv + 4), b0 = *(const f32x4*)(lb + colv), b1 = *(const f32x4*)(lb + colv + 4);
        { const int r = tid >> 2, p = tid & 3; const f32x4* pp = (const f32x4*)(lnp + ((row0 + r) * 32 + 8 * p) * 2); float s1 = 0.f, s2 = 0.f;
#pragma unroll
          for (int i = 0; i < 4; ++i) { const f32x4 v = pp[i]; s1 += v[0] + v[2]; s2 += v[1] + v[3]; }
          s1 += __shfl_xor(s1, 1); s1 += __shfl_xor(s1, 2); s2 += __shfl_xor(s2, 1); s2 += __shfl_xor(s2, 2);
          const float mu = s1 * (1.0f / 2048.0f), var = fmaxf(s2 * (1.0f / 2048.0f) - mu * mu, 0.f);
          if (p == 0) { ST[2 * r] = mu; ST[2 * r + 1] = 1.0f / sqrtf(var + EPS); } }
        if (tid < 128) BS[tid] = bs[g * 128 + tid];
#pragma unroll
        for (int i = 0; i < 4; ++i) { const int item = tid + 512 * i, t = item >> 4, sg = item & 15; *(LAS u32x4*)(F.lds + SG2_WS + (t * 136 + sg * 8) * 2) = wmv[i]; }
        LDS_BARRIER();
#pragma unroll
        for (int i = 0; i < 8; ++i) { const int s = (tid >> 5) + 16 * i; const u32x4 x = xv[i]; const float mu = ST[2 * s], rs = ST[2 * s + 1];
            u32x4 o; o.x = pk2((bflo(x.x) - mu) * rs * g0[0] + b0[0], (bfhi(x.x) - mu) * rs * g0[1] + b0[1]); o.y = pk2((bflo(x.y) - mu) * rs * g0[2] + b0[2], (bfhi(x.y) - mu) * rs * g0[3] + b0[3]);
            o.z = pk2((bflo(x.z) - mu) * rs * g1[0] + b1[0], (bfhi(x.z) - mu) * rs * g1[1] + b1[1]); o.w = pk2((bflo(x.w) - mu) * rs * g1[2] + b1[2], (bfhi(x.w) - mu) * rs * g1[3] + b1[3]);
            *(LAS u32x4*)(F.lds + SG2_VI + (s * 264 + cg8 * 8) * 2) = o; }
        u32x4 uv[2][4];
#pragma unroll
        for (int p = 0; p < 2; ++p)
#pragma unroll
            for (int i = 0; i < 4; ++i) { const int idx = tid + 512 * i, tl = idx >> 5, c8 = idx & 31; uv[p][i] = __builtin_nontemporal_load((const u32x4*)(Z + (row0 + 64 * p + tl) * 4096 + g * 256 + c8 * 8)); }
        LDS_BARRIER();
        f32x16 acc[4] = {};
#pragma unroll
        for (int ks = 0; ks < 8; ++ks) { const bf16x8 bb = tr_frag(F.lds + SG2_VI + (16 * ks * 264 + 32 * wave) * 2, 528, lane);
#pragma unroll
            for (int ti = 0; ti < 4; ++ti) { const bf16x8 a = *(const LAS bf16x8*)(F.lds + SG2_WS + ((32 * ti + r32) * 136 + 16 * ks + 8 * hh) * 2); acc[ti] = MFMA32(a, bb, acc[ti]); } }
        LDS_BARRIER();
#pragma unroll
        for (int p = 0; p < 2; ++p) {
#pragma unroll
            for (int tt = 0; tt < 2; ++tt)
#pragma unroll
                for (int r = 0; r < 16; ++r) { const int tl = 32 * tt + (r & 3) + 8 * (r >> 2) + 4 * hh; SF[tl * 260 + 32 * wave + r32] = acc[2 * p + tt][r] + BS[64 * p + tl]; }
            LDS_BARRIER();
#pragma unroll
            for (int i = 0; i < 4; ++i) { const int idx = tid + 512 * i, tl = idx >> 5, c8 = idx & 31; const size_t row = row0 + 64 * p + tl; const int col = g * 256 + c8 * 8;
                const f32x4 f0 = *(const LAS f32x4*)(SF + tl * 260 + c8 * 8), f1 = *(const LAS f32x4*)(SF + tl * 260 + c8 * 8 + 4);
                const u32x4 x = uv[p][i];
                u32x4 o; o.x = pk2(bflo(x.x) * f0[0], bfhi(x.x) * f0[1]); o.y = pk2(bflo(x.y) * f0[2], bfhi(x.y) * f0[3]); o.z = pk2(bflo(x.z) * f1[0], bfhi(x.z) * f1[1]); o.w = pk2(bflo(x.w) * f1[2], bfhi(x.w) * f1[3]);
                pg8::st16(OUT + row * 2048 + col, o); }
            LDS_BARRIER();
        }
    }
}
__device__ __forceinline__ void final_norm(Frame& F, const float* ssq, const float* fg) {
    const int gw = F.vcu * NWAVES + F.wave, NGW = F.G * NWAVES, lane = F.lane; const bf16* XB = (const bf16*)(F.ws + WS_XB);
    for (int m = gw; m < M; m += NGW) {
        float s = (lane < 16) ? ssq[(size_t)m * 16 + lane] : 0.f; s = wave_sum(s);
        const float r = 1.0f / sqrtf(s * (1.0f / 1024.0f) + EPS);
        const unsigned long long* xi = (const unsigned long long*)(XB + (size_t)m * D) + lane; f32x4* xo = (f32x4*)(F.out + (size_t)m * D) + lane; const f32x4* gp = (const f32x4*)fg + lane;
#pragma unroll
        for (int j = 0; j < 4; ++j) { const unsigned long long w = __builtin_nontemporal_load(xi + 64 * j); const unsigned w0 = (unsigned)w, w1 = (unsigned)(w >> 32); const f32x4 gg = gp[64 * j];
            __builtin_nontemporal_store((f32x4){bflo(w0) * r * gg[0], bfhi(w0) * r * gg[1], bflo(w1) * r * gg[2], bfhi(w1) * r * gg[3]}, xo + 64 * j); }
    }
}

struct Args { const float* in[22]; float* out; unsigned char* ws; int ph_lo, ph_hi; };
constexpr int NPHASE = 26;
__global__ void __launch_bounds__(NWAVES * 64, 2) mk_fwd(Args args) {
    extern __shared__ __attribute__((aligned(16))) unsigned char lds_raw[];
    __builtin_assume(threadIdx.y == 0); __builtin_assume(threadIdx.z == 0);
    const int wv0 = __builtin_amdgcn_readfirstlane((int)threadIdx.x >> 6);
    Frame F;
    F.lds = (ldsp)lds_raw;
    F.inp = args.in;
    F.out = args.out; F.ws = args.ws;
    cg::grid_group grid = cg::this_grid();
    { const int t0 = mk_ltid(wv0); for (int u = t0; u < 128; u += NWAVES * 64) ((LAS unsigned*)(F.lds + LDSCTL_OFF))[u] = 0u; __syncthreads();
    }
    XcdBarrier bar = xcd_barrier_post((unsigned*)args.ws + CW_BAR, (volatile LAS unsigned*)(F.lds + LDSCTL_OFF) + 8, mk_ltid(wv0));
#ifndef MK_REP_N
#define MK_REP_N 0
#endif
#ifndef MK_REP_MATCH
#define MK_REP_MATCH(ph, slot, kind) false
#endif
#ifndef MK_EXTRA_SYNCS
#define MK_EXTRA_SYNCS 0
#endif
    int rep = 0;
    for (int ph = args.ph_lo; ph < args.ph_hi; ) {
        bool did = true;
        F.tid = mk_ltid(wv0); F.lane = F.tid & 63; F.wave = __builtin_amdgcn_readfirstlane(F.tid >> 6);
        int bx = blockIdx.x, gd = gridDim.x; asm volatile("" : "+s"(bx), "+s"(gd)); F.G = gd; F.vcu = (gd % 8 == 0) ? (bx % 8) * (gd / 8) + bx / 8 : bx;
        unsigned long long wsi = (unsigned long long)args.ws; asm volatile("" : "+s"(wsi)); unsigned char* ws = (unsigned char*)(__attribute__((address_space(1))) unsigned char*)wsi; F.ws = ws;
        float* SSQ = (float*)(ws + WS_SSQ); bf16* XB = (bf16*)(ws + WS_XB); bf16* PROJ = (bf16*)(ws + WS_PROJ);
        if (ph == 0) {
#ifndef DIS_P0
 p0_prologue(F);
#endif
 }
        else if (ph == NPHASE - 1) {
#ifndef DIS_FIN
 final_norm(F, SSQ, F.in_(3));
#endif
 }
        else {
            const int layer = (ph - 1) / 6, slot = (ph - 1) % 6, kind = layer % 3, j = layer / 3;
            if (slot == 0) {
                if (kind == 2) {
                    pg8::Gemm g{XB, (const bf16*)(ws + WS_W + W_CIN), M, 4096, D}; pg8::StaticOrder S; S.init(M, 4096, F.G, bx);
                    RstdPre pre{&S, SSQ, (LAS float*)(F.lds + RS_OFF)}; pg8::EpiGeluLn E{PROJ, (const LAS float*)(F.lds + RS_OFF), (float*)(ws + WS_LNP)};
#ifndef DIS_G3
                    pg8::gemm_phase<pg8::EpiGeluLn, pg8::StaticOrder, PG8_ALIGN, PG8_SP2, RstdPre>(F.lds, g, S, E, wv0, pre);
#endif
                } else {
                    const int N = (kind == 0) ? 3072 : 4096;
                    pg8::Gemm g{XB, (const bf16*)(ws + WS_W + ((kind == 0) ? W_AIN + j * SZ_AIN : W_BIN)), M, N, D}; pg8::StaticOrder S; S.init(M, N, F.G, bx);
                    RstdPre pre{&S, SSQ, (LAS float*)(F.lds + RS_OFF)}; pg8::EpiScaleBf16 E{PROJ, (kind == 0) ? 1024 : 4096, (const LAS float*)(F.lds + RS_OFF), (kind == 0) ? 1024 : 0, (size_t)16 * MiB, attn_body::C2};
#ifndef DIS_G1
                    pg8::gemm_phase<pg8::EpiScaleBf16, pg8::StaticOrder, PG8_ALIGN, PG8_SP2, RstdPre>(F.lds, g, S, E, wv0, pre);
#endif
#ifndef DIS_GATE
                    if (kind == 0) gate_items<0>(F, XB, (const bf16*)(ws + WS_WG) + (size_t)j * 16384, SSQ, F.in_(5) + j * 16, nullptr, (float*)(ws + WS_LOGF), nullptr);
                    else gate_items<1>(F, XB, (const bf16*)(ws + WS_WG) + (size_t)2 * 16384, SSQ, F.in_(10), F.in_(11), (float*)(ws + WS_IG), (float*)(ws + WS_LF));
#endif
                }
            } else if (slot == 1) {
                if (kind == 0) {
                    const attn_body::AttnTensors AT{(const attn_body::bf16*)PROJ, (const attn_body::bf16*)(ws + WS_PROJ + 32 * MiB), (const attn_body::bf16*)(ws + WS_PROJ + 64 * MiB), (attn_body::bf16*)PROJ, (const float*)(ws + WS_LOGF)};
                    const attn_body::StaticOrder S((int)F.G, bx);
#ifdef MK_ATTN_TWICE
                    { const attn_body::AttnTensors AT0{AT.Q, AT.K, AT.V, (attn_body::bf16*)(ws + WS_S1), AT.LOGF}; attn_body::attn_phase<attn_body::StaticOrder>((char*)lds_raw, AT0, S, wv0); xcd_barrier(bar, F.tid); }
#endif
#ifndef DIS_ATTN
                    attn_body::attn_phase<attn_body::StaticOrder>((char*)lds_raw, AT, S, wv0);
#endif
                } else if (kind == 1) {
#ifndef DIS_PA
                    mlstm_pass_a(F, PROJ, (const float*)(ws + WS_IG), (const float*)(ws + WS_LF), F.in_(8), F.in_(9), (bf16*)F.out, (float*)(ws + WS_NS), (float*)(ws + WS_MS));
#endif
                } else {
#ifndef DIS_SGU
                    sgu_phase2(F, PROJ, (const float*)(ws + WS_LNP), F.in_(15), F.in_(16), (const bf16*)(ws + WS_WM), F.in_(18), (bf16*)(ws + WS_S1));
#endif
                }
            } else if (slot == 2) {
#ifndef DIS_PB
                if (kind == 1) mlstm_pass_b(F, PROJ, (const float*)(ws + WS_IG), (const float*)(ws + WS_LF), F.in_(8), F.in_(9), (const bf16*)F.out, (const float*)(ws + WS_NS), (const float*)(ws + WS_MS), F.in_(12), (bf16*)(ws + WS_S2));
                else
#endif
                did = false;
            } else if (slot == 3 || slot == 5) {
                const bf16* A; const bf16* Bt; int K;
                if (slot == 5) { A = PROJ; Bt = (const bf16*)(ws + WS_W + W_DN + layer * SZ_DN); K = DFF; }
                else if (kind == 0) { A = PROJ; Bt = (const bf16*)(ws + WS_W + W_AOUT + j * SZ_AOUT); K = D; }
                else if (kind == 1) { A = (const bf16*)(ws + WS_S2); Bt = (const bf16*)(ws + WS_W + W_BOUT); K = D; }
                else { A = (const bf16*)(ws + WS_S1); Bt = (const bf16*)(ws + WS_W + W_COUT); K = 2048; }
                pg8::Gemm g{A, Bt, M, D, K}; pg8::StaticOrder S; S.init(M, D, F.G, bx);
#ifdef MK_RES_TWICE
                if (MK_RES_TWICE(slot, kind)) { bf16* scr = (slot == 5) ? (bf16*)(ws + WS_S1) : (kind == 0) ? (bf16*)(ws + WS_PROJ + 64 * MiB) : PROJ;
                    pg8::EpiResidualB E0{XB, scr, (float*)(ws + WS_LNP)}; pg8::gemm_phase<pg8::EpiResidualB, pg8::StaticOrder, false, PG8_SP2>(F.lds, g, S, E0, wv0); xcd_barrier(bar, F.tid); }
#endif
                pg8::EpiResidualB E{XB, XB, SSQ};
#ifndef DIS_G4
                pg8::gemm_phase<pg8::EpiResidualB, pg8::StaticOrder, false, PG8_SP2>(F.lds, g, S, E, wv0);
#endif
            } else {
                pg8::Gemm g{XB, (const bf16*)(ws + WS_W + W_GU + layer * SZ_GU), M, 2 * DFF, D}; pg8::StaticOrder S; S.init(M, 2 * DFF, F.G, bx);
                RstdPre pre{&S, SSQ, (LAS float*)(F.lds + RS_OFF)}; pg8::EpiSwiGLU E{PROJ, (const LAS float*)(F.lds + RS_OFF)};
#ifndef DIS_G2
                pg8::gemm_phase<pg8::EpiSwiGLU, pg8::StaticOrder, PG8_ALIGN, PG8_SP2, RstdPre>(F.lds, g, S, E, wv0, pre);
                if (F.G == 256 && layer < 3 && bx >= 128) p0_convert(F, layer + 1, false, (bx - 128) * NWAVES + F.wave, 128 * NWAVES, P0_FFN);
#endif
            }
        }
        if (did && ph + 1 < args.ph_hi) { const int ns = (MK_EXTRA_SYNCS > 0 && ph == 1) ? 1 + MK_EXTRA_SYNCS : 1;
            if (args.ph_hi < 0) grid.sync();
            for (int k = 0; k < ns; ++k) xcd_barrier(bar, F.tid); }
        if (MK_REP_N > 0 && ph > 0 && ph < NPHASE - 1 && MK_REP_MATCH(ph, ((ph - 1) % 6), (((ph - 1) / 6) % 3)) && rep < MK_REP_N) ++rep; else if (MK_REP_N > 0 && ph == 0 && MK_REP_MATCH(0, -1, -1) && rep < MK_REP_N) ++rep; else { rep = 0; ++ph; }
    }
}

#ifndef MK_PER_PHASE
#define MK_PER_PHASE 0
#endif
extern "C" void kernel_launch(void* const* d_in, const int* in_sizes, int n_in, void* d_out, int out_size, void* d_ws, size_t ws_size, hipStream_t stream) {
    static int grid = 0;
    if (grid == 0) {
        if (n_in != 22 || out_size != M * D || ws_size < WS_END) { fprintf(stderr, "kernel_launch: unexpected shapes (n_in %d out %d ws %zu)\n", n_in, out_size, ws_size); grid = -1; return; }
        int dev = 0, cus = 0, per_cu = 0;
        (void)hipGetDevice(&dev); (void)hipDeviceGetAttribute(&cus, hipDeviceAttributeMultiprocessorCount, dev);
        if (hipFuncSetAttribute((const void*)mk_fwd, hipFuncAttributeMaxDynamicSharedMemorySize, LDS_BYTES) != hipSuccess) { fprintf(stderr, "kernel_launch: hipFuncSetAttribute failed\n"); grid = -1; return; }
        if (hipOccupancyMaxActiveBlocksPerMultiprocessor(&per_cu, (const void*)mk_fwd, NWAVES * 64, LDS_BYTES) != hipSuccess || per_cu < 1) { fprintf(stderr, "kernel_launch: occupancy query says %d\n", per_cu); per_cu = 1; }
        (void)hipGetLastError();
        grid = cus;
        fprintf(stderr, "kernel_launch: grid %d (per_cu %d)\n", grid, per_cu);
    }
    if (grid < 0) return;
    if (hipMemsetAsync(d_ws, 0, CTL_ZERO_BYTES, stream) != hipSuccess) { fprintf(stderr, "kernel_launch: memset failed\n"); return; }
    Args a{};
    for (int i = 0; i < 22; ++i) a.in[i] = (const float*)d_in[i];
    a.out = (float*)d_out; a.ws = (unsigned char*)d_ws;
#if MK_PER_PHASE
    for (int ph = 0; ph < NPHASE; ++ph) { a.ph_lo = ph; a.ph_hi = ph + 1; void* kargs[] = {&a};
        hipError_t e = hipLaunchCooperativeKernel((const void*)mk_fwd, dim3(grid), dim3(NWAVES * 64), kargs, LDS_BYTES, stream);
        if (e != hipSuccess) { fprintf(stderr, "launch failed: %s\n", hipGetErrorString(e)); break; } }
#else
    a.ph_lo = 0; a.ph_hi = NPHASE; void* kargs[] = {&a};
    hipError_t e = hipLaunchCooperativeKernel((const void*)mk_fwd, dim3(grid), dim3(NWAVES * 64), kargs, LDS_BYTES, stream);
    if (e != hipSuccess) fprintf(stderr, "cooperative launch failed: %s (grid %d)\n", hipGetErrorString(e), grid);
#endif
}
```

```cpp
#include <hip/hip_cooperative_groups.h>
#include <hip/hip_runtime.h>
__device__ __forceinline__ int mk_ltid(int wv) { unsigned z = 0u; asm volatile("" : "+s"(z)); int t = (wv << 6) | (int)__builtin_amdgcn_mbcnt_hi(~0u, __builtin_amdgcn_mbcnt_lo(~0u, z)); asm volatile("" : "+v"(t)); return t; }
#include <hip/hip_runtime.h>
#include <cstdio>
#include <cstdint>
namespace pg8 {
#define PG8_LAS __attribute__((address_space(3)))
typedef unsigned short bf16_t;
typedef short bf16x8 __attribute__((ext_vector_type(8)));
typedef float f32x4 __attribute__((ext_vector_type(4)));
typedef unsigned u32x4 __attribute__((ext_vector_type(4)));
constexpr int BM = 256, BK = 64, HALF = 128, HTB = HALF * BK * 2  , STAGE_BYTES = 8 * HTB, NXCD = 8, WGM = 2;

__host__ __device__ __forceinline__ int lds_byte(int r, int c) { const int st = (r >> 4) * 2 + (c >> 5), rr = r & 15, cc = c & 31, ob = rr * 64 + cc * 2; return st * 1024 + (ob ^ (((ob >> 9) & 1) << 5)); }
__host__ __device__ __forceinline__ void stage_rc(int b, int& R, int& C) { const int st = b / 1024, sb = b % 1024, swz = sb ^ (((sb >> 9) & 1) << 5); R = (st >> 1) * 16 + swz / 64; C = (st & 1) * 32 + (swz % 64) / 2; }
__host__ __device__ __forceinline__ int perm32(int rho) { const int n = rho >> 4, i = rho & 15; return 8 * (i >> 2) + 4 * n + (i & 3); }

struct Unit { int pm, pn, ord; };
struct Gemm { const bf16_t* A; const bf16_t* Bt; int M, N, K; };

struct StaticOrder {
    int nM, nN, nwg, G, c;
    __host__ __device__ void init(int M, int N, int G_, int c_) { nM = M / BM; nN = N / BM; nwg = nM * nN; G = G_; c = c_; }
    __host__ __device__ bool next(int i, Unit& u) const {
        const long L = (long)i * G + c; if (L >= nwg) return false;
        int wgid = (int)L; { const int q = nwg / NXCD, r = nwg % NXCD, xcd = wgid % NXCD, off = wgid / NXCD; wgid = (xcd < r ? xcd * (q + 1) : r * (q + 1) + (xcd - r) * q) + off; }
#if defined(PG8_NMAJOR) && PG8_NMAJOR
        u.pm = wgid % nM; u.pn = wgid / nM; u.ord = i; return true;
#else
        const int nig = WGM * nN, gid = wgid / nig, fm = gid * WGM, gsz = (nM - fm) < WGM ? (nM - fm) : WGM;
        u.pm = fm + ((wgid % nig) % gsz); u.pn = (wgid % nig) / gsz; u.ord = i; return true;
#endif
    }
    __device__ __forceinline__ void a_ready(const Unit&) const {}
    __device__ __forceinline__ void done(const Unit&) const {}
};

__device__ __forceinline__ unsigned cvt_pk_bf16(float lo, float hi) { unsigned r; asm volatile("v_cvt_pk_bf16_f32 %0, %1, %2" : "=v"(r) : "v"(lo), "v"(hi)); return r; }
typedef float f32x2 __attribute__((ext_vector_type(2)));
__device__ __forceinline__ f32x2 gelu_pk(f32x2 v) {
    const f32x2 av = __builtin_elementwise_abs(v), d = av * 0.2316418882f + 1.0f;
    f32x2 t; t.x = __builtin_amdgcn_rcpf(d.x); t.y = __builtin_amdgcn_rcpf(d.y);
    f32x2 q = t * 0.5307027145f + (-0.7265760135f); q = q * t + 0.7107068705f; q = q * t + (-0.142248368f); q = q * t + 0.127414796f; q = q * t;
    const f32x2 s = (v * v) * (-0.72134752044f);
    f32x2 e; e.x = __builtin_amdgcn_exp2f(s.x); e.y = __builtin_amdgcn_exp2f(s.y);
    const f32x2 m = v * (q * e), r = v - m;
    f32x2 o; o.x = v.x < 0.f ? m.x : r.x; o.y = v.y < 0.f ? m.y : r.y; return o;
}

__device__ __forceinline__ float row_rstd(const float* ssq, int row, int fq) {
    const f32x4 v = *(const f32x4*)(ssq + (size_t)row * 16 + 4 * fq);
    float s = (v[0] + v[1]) + (v[2] + v[3]); s += __shfl_xor(s, 16); s += __shfl_xor(s, 32);
    return 1.0f / sqrtf(s * (1.0f / 1024.0f) + 1e-6f);
}
__device__ __forceinline__ unsigned pkbf(float lo, float hi) { typedef float f2_t __attribute__((ext_vector_type(2))); typedef __bf16 b2_t __attribute__((ext_vector_type(2))); f2_t v = {lo, hi}; b2_t b = __builtin_convertvector(v, b2_t); return __builtin_bit_cast(unsigned, b); }

#ifndef PG8_ST_MODE
#define PG8_ST_MODE 1
#endif
__device__ __forceinline__ void st16(void* p, u32x4 v) {
    asm volatile("global_store_dwordx4 %0, %1, off sc1\n\ts_nop 1" :: "v"(p), "v"(v) : "memory");
}
__device__ __forceinline__ void st16o(const void* base, unsigned off, u32x4 v) { asm volatile("global_store_dwordx4 %0, %1, %2 sc1\n\ts_nop 1" :: "v"(off), "v"(v), "s"(base) : "memory"); }
__device__ __forceinline__ u32x4 ld16o(const void* base, unsigned off) { return *(const u32x4*)((const char*)base + off); }
__device__ __forceinline__ void st16e(void* p, u32x4 v) {
#if PG8_ST_MODE == 0
    *(u32x4*)p = v;
#elif PG8_ST_MODE == 1
    asm volatile("global_store_dwordx4 %0, %1, off sc1\n\ts_nop 1" :: "v"(p), "v"(v) : "memory");
#elif PG8_ST_MODE == 2
    asm volatile("global_store_dwordx4 %0, %1, off sc1 nt\n\ts_nop 1" :: "v"(p), "v"(v) : "memory");
#else
    asm volatile("global_store_dwordx4 %0, %1, off nt\n\ts_nop 1" :: "v"(p), "v"(v) : "memory");
#endif
}
struct EpiScaleBf16 {
    static constexpr bool PERM = true, AFTER_DRAIN = false;
    bf16_t* O; int ldc; const PG8_LAS float* rs; int split_cols; size_t split_stride; float scale0;
    __device__ __forceinline__ void operator()(const f32x4 (&acc)[2][2][4][2], const Unit& u, int wr, int wc, int fr, int fq) const {
        const int row0 = u.pm * BM + wr * 64 + fr; int colt = u.pn * BM; bf16_t* base = O;
        float sc = 1.f; if (split_cols) { const int t = colt / split_cols; base += (size_t)t * split_stride; colt -= t * split_cols; if (t == 0) sc = scale0; }
        const int col0 = colt + wc * 32 + 8 * fq;
#pragma unroll
        for (int ai = 0; ai < 2; ++ai)
#pragma unroll
            for (int m = 0; m < 4; ++m) { const int row = row0 + ai * HALF + m * 16; const float r = rs[u.ord * 256 + wr * 64 + fr + ai * HALF + m * 16] * sc; bf16_t* rowp = base + (size_t)row * ldc + col0;
#pragma unroll
                for (int bj = 0; bj < 2; ++bj) { const f32x4 v0 = acc[ai][bj][m][0] * r, v1 = acc[ai][bj][m][1] * r;
                    u32x4 w; w.x = pkbf(v0[0], v0[1]); w.y = pkbf(v0[2], v0[3]); w.z = pkbf(v1[0], v1[1]); w.w = pkbf(v1[2], v1[3]);
                    st16e(rowp + bj * HALF, w); } }
    }
};
__device__ __forceinline__ float silu_f(float x) { return x * __builtin_amdgcn_rcpf(1.0f + __builtin_amdgcn_exp2f(-1.4426950408889634f * x)); }
struct EpiSwiGLU {
    static constexpr bool PERM = true, AFTER_DRAIN = false;
    bf16_t* O; const PG8_LAS float* rs;
    __device__ __forceinline__ void operator()(const f32x4 (&acc)[2][2][4][2], const Unit& u, int wr, int wc, int fr, int fq) const {
        const int row0 = u.pm * BM + wr * 64 + fr, col0 = u.pn * HALF + wc * 32 + 8 * fq;
#pragma unroll
        for (int ai = 0; ai < 2; ++ai)
#pragma unroll
            for (int m = 0; m < 4; ++m) { const int row = row0 + ai * HALF + m * 16; const float r = rs[u.ord * 256 + wr * 64 + fr + ai * HALF + m * 16];
                const f32x4 g0 = acc[ai][0][m][0] * r, g1 = acc[ai][0][m][1] * r, u0 = acc[ai][1][m][0] * r, u1 = acc[ai][1][m][1] * r;
                float a[8];
#pragma unroll
                for (int j = 0; j < 4; ++j) { a[j] = silu_f(g0[j]) * u0[j]; a[4 + j] = silu_f(g1[j]) * u1[j]; }
                u32x4 w; w.x = pkbf(a[0], a[1]); w.y = pkbf(a[2], a[3]); w.z = pkbf(a[4], a[5]); w.w = pkbf(a[6], a[7]);
                st16e(O + (size_t)row * 2816 + col0, w); }
    }
};
struct EpiGeluLn {
    static constexpr bool PERM = true, AFTER_DRAIN = false;
    bf16_t* O; const PG8_LAS float* rs; float* lnp;
    __device__ __forceinline__ void operator()(const f32x4 (&acc)[2][2][4][2], const Unit& u, int wr, int wc, int fr, int fq) const {
        const int row0 = u.pm * BM + wr * 64 + fr, col0 = u.pn * BM + wc * 32 + 8 * fq;
#pragma unroll
        for (int ai = 0; ai < 2; ++ai)
#pragma unroll
            for (int m = 0; m < 4; ++m) { const int row = row0 + ai * HALF + m * 16; const float r = rs[u.ord * 256 + wr * 64 + fr + ai * HALF + m * 16]; bf16_t* rowp = O + (size_t)row * 4096 + col0;
                float s1 = 0.f, s2 = 0.f;
#pragma unroll
                for (int bj = 0; bj < 2; ++bj) { const f32x4 v0 = acc[ai][bj][m][0] * r, v1 = acc[ai][bj][m][1] * r;
                    const f32x2 a = gelu_pk((f32x2){v0[0], v0[1]}), b = gelu_pk((f32x2){v0[2], v0[3]}), c = gelu_pk((f32x2){v1[0], v1[1]}), d = gelu_pk((f32x2){v1[2], v1[3]});
                    s1 += ((a.x + a.y) + (b.x + b.y)) + ((c.x + c.y) + (d.x + d.y));
                    s2 += ((a.x * a.x + a.y * a.y) + (b.x * b.x + b.y * b.y)) + ((c.x * c.x + c.y * c.y) + (d.x * d.x + d.y * d.y));
                    u32x4 w; w.x = pkbf(a.x, a.y); w.y = pkbf(b.x, b.y); w.z = pkbf(c.x, c.y); w.w = pkbf(d.x, d.y);
                    st16e(rowp + bj * HALF, w); }
                if (u.pn >= 8) { s1 += __shfl_xor(s1, 16); s1 += __shfl_xor(s1, 32); s2 += __shfl_xor(s2, 16); s2 += __shfl_xor(s2, 32);
                    if (fq == 0) *(f32x2*)(lnp + ((size_t)row * 32 + (u.pn - 8) * 4 + wc) * 2) = (f32x2){s1, s2}; } }
    }
};
struct EpiResidual {
    static constexpr bool PERM = true, AFTER_DRAIN = false;
    const float* X; float* Xo; bf16_t* XB; float* ssq;
    __device__ __forceinline__ void operator()(const f32x4 (&acc)[2][2][4][2], const Unit& u, int wr, int wc, int fr, int fq) const {
        const int row0 = u.pm * BM + wr * 64 + fr, col0 = u.pn * BM + wc * 32 + 8 * fq;
#pragma unroll
        for (int ai = 0; ai < 2; ++ai)
#pragma unroll
            for (int m = 0; m < 4; ++m) { const int row = row0 + ai * HALF + m * 16; const float* xp = X + (size_t)row * 1024 + col0; float* xq = Xo + (size_t)row * 1024 + col0; bf16_t* bp = XB + (size_t)row * 1024 + col0; float q = 0.f;
#pragma unroll
                for (int bj = 0; bj < 2; ++bj) { f32x4 x0 = *(const f32x4*)(xp + bj * HALF), x1 = *(const f32x4*)(xp + bj * HALF + 4);
                    x0 += acc[ai][bj][m][0]; x1 += acc[ai][bj][m][1];
                    *(f32x4*)(xq + bj * HALF) = x0; *(f32x4*)(xq + bj * HALF + 4) = x1;
                    q += ((x0[0] * x0[0] + x0[1] * x0[1]) + (x0[2] * x0[2] + x0[3] * x0[3])) + ((x1[0] * x1[0] + x1[1] * x1[1]) + (x1[2] * x1[2] + x1[3] * x1[3]));
                    u32x4 w; w.x = pkbf(x0[0], x0[1]); w.y = pkbf(x0[2], x0[3]); w.z = pkbf(x1[0], x1[1]); w.w = pkbf(x1[2], x1[3]);
                    *(u32x4*)(bp + bj * HALF) = w; }
                q += __shfl_xor(q, 16); q += __shfl_xor(q, 32);
                if (fq == 0) ssq[(size_t)row * 16 + u.pn * 4 + wc] = q; }
    }
};

struct EpiResidualLds {
    static constexpr bool PERM = true, AFTER_DRAIN = true;
    const float* X; float* Xo; bf16_t* XB; float* ssq;
    __device__ __forceinline__ void operator()(const f32x4 (&)[2][2][4][2], const Unit&, int, int, int, int) const {}
    __device__ __forceinline__ void fused(f32x4 (&acc)[2][2][4][2], const Unit& u, int wr, int wc, int fr, int fq, PG8_LAS unsigned char* lds, int wid, int lane) const {
#pragma unroll
        for (int ai = 0; ai < 2; ++ai) {
#pragma unroll
            for (int m = 0; m < 4; ++m) { const int rl = 64 * wr + 16 * m + fr;
#pragma unroll
                for (int bj = 0; bj < 2; ++bj)
#pragma unroll
                    for (int n = 0; n < 2; ++n) { const int ch = 32 * bj + 8 * wc + 2 * fq + n; *(PG8_LAS f32x4*)(lds + rl * 1024 + ((ch ^ (rl & 7)) << 4)) = acc[ai][bj][m][n]; } }
            asm volatile("s_waitcnt lgkmcnt(0)" ::: "memory"); __builtin_amdgcn_s_barrier(); asm volatile("" ::: "memory");
#pragma unroll 4
            for (int i = 0; i < 16; ++i) { const int rl = 16 * wid + i; const size_t off = (size_t)(u.pm * BM + 128 * ai + rl) * 1024 + u.pn * BM + 4 * lane;
                const f32x4 a = *(const PG8_LAS f32x4*)(lds + rl * 1024 + ((lane ^ (rl & 7)) << 4));
                f32x4 x = *(const f32x4*)(X + off); x += a; *(f32x4*)(Xo + off) = x;
                float q = (x[0] * x[0] + x[1] * x[1]) + (x[2] * x[2] + x[3] * x[3]);
                typedef unsigned u32x2_t __attribute__((ext_vector_type(2))); u32x2_t w; w.x = pkbf(x[0], x[1]); w.y = pkbf(x[2], x[3]); *(u32x2_t*)(XB + off) = w;
#pragma unroll
                for (int o = 1; o < 64; o <<= 1) q += __shfl_xor(q, o);
                if (lane == 0) *(f32x4*)(ssq + (size_t)(u.pm * BM + 128 * ai + rl) * 16 + u.pn * 4) = (f32x4){q, 0.f, 0.f, 0.f}; }
            asm volatile("s_waitcnt lgkmcnt(0)" ::: "memory"); __builtin_amdgcn_s_barrier(); asm volatile("" ::: "memory");
        }
    }
};

struct EpiResidualB {
    static constexpr bool PERM = true, AFTER_DRAIN = false;
    bf16_t* XB; bf16_t* XBo; float* ssq;
    __device__ __forceinline__ void operator()(const f32x4 (&acc)[2][2][4][2], const Unit& u, int wr, int wc, int fr, int fq) const {
        const int row0 = u.pm * BM + wr * 64 + fr, col0 = u.pn * BM + wc * 32 + 8 * fq;
        const unsigned off0 = (unsigned)(row0 * 1024 + col0) * 2u;
        f32x4 s[2][4][2][2]; u32x4 xv[2][4][2];
#pragma unroll
        for (int ai = 0; ai < 2; ++ai)
#pragma unroll
            for (int m = 0; m < 4; ++m)
#pragma unroll
                for (int bj = 0; bj < 2; ++bj) xv[ai][m][bj] = ld16o(XB, off0 + (unsigned)((ai * HALF + m * 16) * 2048 + bj * HALF * 2));
#pragma unroll
        for (int ai = 0; ai < 2; ++ai) {
#pragma unroll
            for (int m = 0; m < 4; ++m)
#pragma unroll
                for (int bj = 0; bj < 2; ++bj) { const u32x4 x = xv[ai][m][bj]; const f32x4 a0 = acc[ai][bj][m][0], a1 = acc[ai][bj][m][1];
                    s[ai][m][bj][0] = (f32x4){__uint_as_float(x.x << 16) + a0[0], __uint_as_float(x.x & 0xffff0000u) + a0[1], __uint_as_float(x.y << 16) + a0[2], __uint_as_float(x.y & 0xffff0000u) + a0[3]};
                    s[ai][m][bj][1] = (f32x4){__uint_as_float(x.z << 16) + a1[0], __uint_as_float(x.z & 0xffff0000u) + a1[1], __uint_as_float(x.w << 16) + a1[2], __uint_as_float(x.w & 0xffff0000u) + a1[3]}; }
#pragma unroll
            for (int m = 0; m < 4; ++m)
#pragma unroll
                for (int bj = 0; bj < 2; ++bj) asm volatile("" : "+v"(s[ai][m][bj][0]), "+v"(s[ai][m][bj][1]));
            asm volatile("" ::: "memory"); }
#pragma unroll
        for (int ai = 0; ai < 2; ++ai)
#pragma unroll
            for (int m = 0; m < 4; ++m) { const int row = row0 + ai * HALF + m * 16; float q = 0.f;
#pragma unroll
                for (int bj = 0; bj < 2; ++bj) { const f32x4 a0 = s[ai][m][bj][0], a1 = s[ai][m][bj][1];
                    u32x4 w; w.x = pkbf(a0[0], a0[1]); w.y = pkbf(a0[2], a0[3]); w.z = pkbf(a1[0], a1[1]); w.w = pkbf(a1[2], a1[3]);
                    st16o(XBo, off0 + (unsigned)((ai * HALF + m * 16) * 2048 + bj * HALF * 2), w);
#pragma unroll
                    for (int k = 0; k < 4; ++k) { const float lo = __uint_as_float(w[k] << 16), hi = __uint_as_float(w[k] & 0xffff0000u); q += lo * lo + hi * hi; } }
                q += __shfl_xor(q, 16); q += __shfl_xor(q, 32);
                if (fq == 0) ssq[(size_t)row * 16 + u.pn * 4 + wc] = q; }
    }
};
struct NoPre { __device__ __forceinline__ void issue(int) {} __device__ __forceinline__ void finish(int) {} };
template <class Epi, class Sched, bool ALIGN_EPI = false, bool SP2 = false, class Pre = NoPre>
__device__ __forceinline__ void gemm_phase(PG8_LAS unsigned char* lds, const Gemm g, const Sched& S, const Epi& E, const int wv, Pre pre = Pre()) {
    const int tid = mk_ltid(wv), wid = __builtin_amdgcn_readfirstlane(tid >> 6), lane = tid & 63, wr = wid >> 2, wc = wid & 3, fr = lane & 15, fq = lane >> 4;
    const int K = g.K, nt = K / BK;
    unsigned voffA[2], voffB[2];
#pragma unroll
    for (int i = 0; i < 2; ++i) { int R, C; stage_rc(tid * 16 + i * 8192, R, C); const int Rb = Epi::PERM ? ((R & ~31) + perm32(R & 31)) : R;
        voffA[i] = (unsigned)(R * K + C) * 2u; voffB[i] = (unsigned)(Rb * K + C) * 2u; }
    const size_t kstep = (size_t)(BK * 2);
    const size_t hstep = (size_t)HALF * K * 2;
    const size_t tstep = 2 * hstep;
    const unsigned ldsw = (unsigned)wid * 1024u;
    const int aoff = lds_byte(wr * 64 + fr, fq * 8), boff = lds_byte(wc * 32 + fr, fq * 8);
#define PG8_SA(b, h) (((b) * 2 + (h)) * HTB)
#define PG8_SB(b, h) ((4 + (b) * 2 + (h)) * HTB)
#ifndef PG8_AUX_A
#define PG8_AUX_A 0
#endif
#ifndef PG8_AUX_B
#define PG8_AUX_B 0
#endif
#define PG8_STAGE_X(bufoff, gbase, voff, AUX) do { _Pragma("unroll") for (int _i = 0; _i < 2; ++_i) \
        __builtin_amdgcn_global_load_lds((const unsigned*)((const char*)(gbase) + (voff)[_i]), (PG8_LAS unsigned*)(lds + (bufoff) + ldsw + _i * 8192), 16, 0, AUX); } while (0)
#define PG8_STAGE(bufoff, gbase, voff) PG8_STAGE_X(bufoff, gbase, voff, PG8_AUX_A)
#define PG8_STAGEB(bufoff, gbase, voff) PG8_STAGE_X(bufoff, gbase, voff, PG8_AUX_B)
#define PG8_LDA(dst, b, h) do { _Pragma("unroll") for (int m = 0; m < 4; ++m) _Pragma("unroll") for (int k = 0; k < 2; ++k) dst[m][k] = *(const PG8_LAS bf16x8*)(lds + PG8_SA(b, h) + aoff + m * 2048 + k * 1024); } while (0)
#define PG8_LDB(dst, b, h) do { _Pragma("unroll") for (int n = 0; n < 2; ++n) _Pragma("unroll") for (int k = 0; k < 2; ++k) dst[n][k] = *(const PG8_LAS bf16x8*)(lds + PG8_SB(b, h) + boff + n * 2048 + k * 1024); } while (0)
#define PG8_MMA(ai, bj, At, Bt) do { __builtin_amdgcn_s_setprio(1); _Pragma("unroll") for (int m = 0; m < 4; ++m) _Pragma("unroll") for (int n = 0; n < 2; ++n) _Pragma("unroll") for (int k = 0; k < 2; ++k) \
        acc[ai][bj][m][n] = __builtin_amdgcn_mfma_f32_16x16x32_bf16(Bt[n][k], At[m][k], acc[ai][bj][m][n], 0, 0, 0); __builtin_amdgcn_s_setprio(0); } while (0)
#define PG8_WAIT_V(n) asm volatile("s_waitcnt vmcnt(" #n ")" ::: "memory")
#define PG8_WAIT_L(n) asm volatile("s_waitcnt lgkmcnt(" #n ")" ::: "memory")
#define PG8_BAR __builtin_amdgcn_s_barrier()
#define PG8_SCHED __builtin_amdgcn_sched_barrier(0)
    Unit cur, nxt; int ui = 0;
    if (!S.next(0, cur)) return;
    f32x4 acc[2][2][4][2];
#pragma unroll
    for (int a = 0; a < 2; ++a)
#pragma unroll
        for (int b = 0; b < 2; ++b)
#pragma unroll
            for (int m = 0; m < 4; ++m)
#pragma unroll
                for (int n = 0; n < 2; ++n) acc[a][b][m][n] = (f32x4){0.f, 0.f, 0.f, 0.f};
    bf16x8 At[4][2], B0[2][2], B1[2][2];
    const char* cA = (const char*)g.A + (size_t)cur.pm * tstep; const char* cB = (const char*)g.Bt + (size_t)cur.pn * tstep;
    S.a_ready(cur);
    if constexpr (SP2) {
        pre.issue(tid);
        PG8_STAGEB(PG8_SB(0, 0), cB, voffB); PG8_STAGEB(PG8_SB(0, 1), cB + hstep, voffB); PG8_STAGE(PG8_SA(0, 0), cA, voffA); PG8_STAGE(PG8_SA(0, 1), cA + hstep, voffA);
        pre.finish(tid);
        if (wr == 1) PG8_BAR;
        PG8_WAIT_V(2); PG8_BAR;
        PG8_STAGEB(PG8_SB(1, 0), cB + kstep, voffB); PG8_STAGE(PG8_SA(1, 0), cA + kstep, voffA); PG8_STAGEB(PG8_SB(1, 1), cB + hstep + kstep, voffB);
        PG8_WAIT_V(6); PG8_BAR;
    } else {
        PG8_STAGEB(PG8_SB(0, 0), cB, voffB); PG8_STAGE(PG8_SA(0, 0), cA, voffA); PG8_STAGEB(PG8_SB(0, 1), cB + hstep, voffB); PG8_STAGE(PG8_SA(0, 1), cA + hstep, voffA);
        if (wr == 1) PG8_BAR;
        PG8_WAIT_V(4); PG8_BAR;
        PG8_STAGEB(PG8_SB(1, 0), cB + kstep, voffB); PG8_STAGE(PG8_SA(1, 0), cA + kstep, voffA); PG8_STAGEB(PG8_SB(1, 1), cB + hstep + kstep, voffB);
        PG8_WAIT_V(6); PG8_BAR;
    }
    for (;;) {
        const bool has_next = S.next(ui + 1, nxt);
        const char* nA = has_next ? (const char*)g.A + (size_t)nxt.pm * tstep : cA; const char* nB = has_next ? (const char*)g.Bt + (size_t)nxt.pn * tstep : cB;
        for (int t = 0; t < nt; t += 2) {
            const bool last = (t == nt - 2);
            const char* a1 = cA + (size_t)(t + 1) * kstep;
            const char* a2 = last ? nA : cA + (size_t)(t + 2) * kstep; const char* b2 = last ? nB : cB + (size_t)(t + 2) * kstep;
            const char* a3 = a2 + kstep; const char* b3 = b2 + kstep;
            if (last && has_next) S.a_ready(nxt);
            if constexpr (SP2) {
            PG8_LDB(B0, 0, 0); PG8_LDB(B1, 0, 1); PG8_SCHED; PG8_LDA(At, 0, 0); PG8_STAGE(PG8_SA(1, 1), a1 + hstep, voffA);
            PG8_WAIT_V(8); PG8_WAIT_L(0); PG8_BAR; PG8_MMA(0, 0, At, B0); PG8_MMA(0, 1, At, B1); PG8_BAR; PG8_SCHED;
            PG8_LDA(At, 0, 1); PG8_STAGEB(PG8_SB(0, 0), b2, voffB); PG8_STAGEB(PG8_SB(0, 1), b2 + hstep, voffB); PG8_STAGE(PG8_SA(0, 0), a2, voffA);
            PG8_WAIT_V(8); PG8_WAIT_L(0); PG8_BAR; PG8_MMA(1, 0, At, B0); PG8_MMA(1, 1, At, B1); PG8_BAR; PG8_SCHED;
            PG8_LDB(B0, 1, 0); PG8_LDB(B1, 1, 1); PG8_SCHED; PG8_LDA(At, 1, 0); PG8_STAGE(PG8_SA(0, 1), a2 + hstep, voffA);
            PG8_WAIT_V(8); PG8_WAIT_L(0); PG8_BAR; PG8_MMA(0, 0, At, B0); PG8_MMA(0, 1, At, B1); PG8_BAR; PG8_SCHED;
            PG8_LDA(At, 1, 1); PG8_STAGEB(PG8_SB(1, 0), b3, voffB); PG8_STAGEB(PG8_SB(1, 1), b3 + hstep, voffB); PG8_STAGE(PG8_SA(1, 0), a3, voffA);
            PG8_WAIT_V(8); PG8_WAIT_L(0); PG8_BAR; PG8_MMA(1, 0, At, B0); PG8_MMA(1, 1, At, B1); PG8_BAR; PG8_SCHED;
            } else {
            PG8_LDB(B0, 0, 0); PG8_SCHED; PG8_LDA(At, 0, 0); PG8_STAGE(PG8_SA(1, 1), a1 + hstep, voffA);
            PG8_WAIT_L(8); PG8_BAR; PG8_WAIT_L(0); PG8_MMA(0, 0, At, B0); PG8_BAR; PG8_SCHED;
            PG8_LDB(B1, 0, 1); PG8_STAGEB(PG8_SB(0, 0), b2, voffB);
            PG8_BAR; PG8_WAIT_L(0); PG8_MMA(0, 1, At, B1); PG8_BAR;
            PG8_LDA(At, 0, 1); PG8_STAGE(PG8_SA(0, 0), a2, voffA);
            PG8_BAR; PG8_WAIT_L(0); PG8_MMA(1, 0, At, B0); PG8_BAR; PG8_SCHED;
            PG8_STAGEB(PG8_SB(0, 1), b2 + hstep, voffB);
            PG8_WAIT_V(6); PG8_BAR; PG8_MMA(1, 1, At, B1); PG8_BAR;
            PG8_LDB(B0, 1, 0); PG8_SCHED; PG8_LDA(At, 1, 0); PG8_STAGE(PG8_SA(0, 1), a2 + hstep, voffA);
            PG8_WAIT_L(8); PG8_BAR; PG8_WAIT_L(0); PG8_MMA(0, 0, At, B0); PG8_BAR; PG8_SCHED;
            PG8_LDB(B1, 1, 1); PG8_STAGEB(PG8_SB(1, 0), b3, voffB);
            PG8_BAR; PG8_WAIT_L(0); PG8_MMA(0, 1, At, B1); PG8_BAR;
            PG8_LDA(At, 1, 1); PG8_STAGE(PG8_SA(1, 0), a3, voffA);
            PG8_BAR; PG8_WAIT_L(0); PG8_MMA(1, 0, At, B0); PG8_BAR; PG8_SCHED;
            PG8_STAGEB(PG8_SB(1, 1), b3 + hstep, voffB);
            PG8_WAIT_V(6); PG8_BAR; PG8_MMA(1, 1, At, B1); PG8_BAR;
            }
        }
        if constexpr (ALIGN_EPI) { if (wr == 0) PG8_BAR; }
        if constexpr (!Epi::AFTER_DRAIN) { E(acc, cur, wr, wc, fr, fq); S.done(cur); }
        if (!has_next) break;
#pragma unroll
        for (int a = 0; a < 2; ++a)
#pragma unroll
            for (int b = 0; b < 2; ++b)
#pragma unroll
                for (int m = 0; m < 4; ++m)
#pragma unroll
                    for (int n = 0; n < 2; ++n) acc[a][b][m][n] = (f32x4){0.f, 0.f, 0.f, 0.f};
        cur = nxt; cA = nA; cB = nB; ++ui;
        if constexpr (ALIGN_EPI) { if (wr == 1) PG8_BAR; }
    }
    PG8_WAIT_V(0);
    if constexpr (!ALIGN_EPI) { if (wr == 0) PG8_BAR; }
    PG8_BAR;
    if constexpr (Epi::AFTER_DRAIN) { E.fused(acc, cur, wr, wc, fr, fq, lds, wid, lane); S.done(cur); }
#undef PG8_SA
#undef PG8_SB
#undef PG8_STAGE
#undef PG8_STAGEB
#undef PG8_STAGE_X
#undef PG8_LDA
#undef PG8_LDB
#undef PG8_MMA
#undef PG8_WAIT_V
#undef PG8_WAIT_L
#undef PG8_BAR
#undef PG8_SCHED
}
}

#ifndef PG8_SP2
#define PG8_SP2 true
#endif
#ifndef PG8_ALIGN
#define PG8_ALIGN true
#endif
#include <hip/hip_bf16.h>
#include <cmath>
namespace attn_body {
using bf16=__hip_bfloat16;
using bf16x8=__attribute__((ext_vector_type(8)))short;
using s16x4=__attribute__((ext_vector_type(4)))short;
using f32x16=__attribute__((ext_vector_type(16)))float;
using u32x4=__attribute__((ext_vector_type(4)))unsigned;
constexpr int BATCH=8,NHEAD=16,SEQ=2048,D=64,DM=NHEAD*D;
constexpr int NW=8,QBLK=32,QB=QBLK*NW,KVBLK=64,NQB=SEQ/QB;
constexpr int ATTN_PITCH=DM, ATTN_UNIT_ROWS=QB;
__device__ __forceinline__ int crow(int r,int hi){return (r&3)+8*(r>>2)+4*hi;}
#define SBAR() __builtin_amdgcn_sched_barrier(0)
__device__ __forceinline__ void cmask(f32x16&p0,f32x16&p1,int jb,int qrel,int hi){
  const float NEG=-INFINITY; int kb=64*jb+4*hi;
  #pragma unroll
  for(int r=0;r<16;++r){int kv=kb+(r&3)+8*(r>>2); if(kv>qrel)p0[r]=NEG; if(kv+32>qrel)p1[r]=NEG;}
}

constexpr int NSLOT=3, SLOTB=8192;
constexpr int LDS_K=0, LDS_V=NSLOT*SLOTB, LDS_WS=2*NSLOT*SLOTB, LDS_OST=LDS_WS+NW*64*4, LDS_CB=LDS_OST+NW*4096, LDS_BYTES=LDS_CB+SEQ*4;
constexpr float C2=0.125f*1.4426950408889634f;
__device__ __forceinline__ void glds16(const void*gsrc,unsigned lds_dst){unsigned keep;
  asm volatile("s_mov_b32 %0, m0\n\ts_mov_b32 m0, %2\n\ts_nop 0\n\tglobal_load_lds_dwordx4 %1, off\n\ts_mov_b32 m0, %0":"=&s"(keep):"v"(gsrc),"s"(lds_dst):"memory");}
__device__ __forceinline__ float max3f(float a,float b,float c){float r;asm("v_max3_f32 %0, %1, %2, %3":"=v"(r):"v"(a),"v"(b),"v"(c));return r;}
__device__ __forceinline__ float max2f(float a,float b){float r;asm("v_max_f32_e32 %0, %1, %2":"=v"(r):"v"(a),"v"(b));return r;}
__device__ __forceinline__ float fadd_s(float a,float b){float r;asm("v_add_f32_e32 %0, %1, %2":"=v"(r):"v"(a),"v"(b));return r;}
__device__ __forceinline__ float fsub_s(float a,float b){float r;asm("v_sub_f32_e32 %0, %1, %2":"=v"(r):"v"(a),"v"(b));return r;}
typedef float f32x2_t __attribute__((ext_vector_type(2))); typedef __bf16 bf16x2_t __attribute__((ext_vector_type(2)));
__device__ __forceinline__ unsigned cvtpk_s(float lo,float hi){f32x2_t v={lo,hi};bf16x2_t b=__builtin_convertvector(v,bf16x2_t);return __builtin_bit_cast(unsigned,b);}
#define WAIT_BAR(N) asm volatile("s_waitcnt vmcnt(" #N ") lgkmcnt(0)\n\ts_barrier":::"memory")

__device__ __forceinline__ void qkt(f32x16&p0,f32x16&p1,const char*Kslot,const bf16x8*qr,int r32,int hi){
  const char*kb=Kslot+hi*1024+r32*16;
  #pragma unroll
  for(int d0=0;d0<4;++d0){
    const bf16x8 b0=*reinterpret_cast<const bf16x8*>(kb+d0*2048);
    const bf16x8 b1=*reinterpret_cast<const bf16x8*>(kb+d0*2048+512);
    {p0=__builtin_amdgcn_mfma_f32_32x32x16_bf16(b0,qr[d0],p0,0,0,0);p1=__builtin_amdgcn_mfma_f32_32x32x16_bf16(b1,qr[d0],p1,0,0,0);}}
}
typedef __attribute__((address_space(3))) const char* lds_cptr;
typedef short v4i16_t __attribute__((ext_vector_type(4)));
__device__ __forceinline__ void kload8(bf16x8*kf,lds_cptr kp){
  kf[0]=*(const __attribute__((address_space(3))) bf16x8*)(kp);      kf[1]=*(const __attribute__((address_space(3))) bf16x8*)(kp+512);
  kf[2]=*(const __attribute__((address_space(3))) bf16x8*)(kp+2048); kf[3]=*(const __attribute__((address_space(3))) bf16x8*)(kp+2560);
  kf[4]=*(const __attribute__((address_space(3))) bf16x8*)(kp+4096); kf[5]=*(const __attribute__((address_space(3))) bf16x8*)(kp+4608);
  kf[6]=*(const __attribute__((address_space(3))) bf16x8*)(kp+6144); kf[7]=*(const __attribute__((address_space(3))) bf16x8*)(kp+6656);
}
__device__ __forceinline__ void kload2(bf16x8*kf,lds_cptr kp,int j){ kf[2*j]=*(const __attribute__((address_space(3))) bf16x8*)(kp+j*2048); kf[2*j+1]=*(const __attribute__((address_space(3))) bf16x8*)(kp+j*2048+512); }
__device__ __forceinline__ s16x4 vtr(lds_cptr p){ return __builtin_bit_cast(s16x4,__builtin_amdgcn_ds_read_tr16_b64_v4i16((__attribute__((address_space(3))) v4i16_t*)p)); }
__device__ __forceinline__ float rowmax(const f32x16&p0,const f32x16&p1){
  float a=max3f(p0[0],p0[1],p1[0]),b=max3f(p0[2],p0[3],p1[1]);a=max3f(a,p1[2],p1[3]);
  #pragma unroll
  for(int r=4;r<16;r+=4){a=max3f(a,p0[r],p0[r+1]);b=max3f(b,p0[r+2],p0[r+3]);a=max3f(a,p1[r],p1[r+1]);b=max3f(b,p1[r+2],p1[r+3]);}
  const float m=max2f(a,b);
  auto rr=__builtin_amdgcn_permlane32_swap(__float_as_uint(m),__float_as_uint(m),false,false);
  return max2f(__uint_as_float(rr[0]),__uint_as_float(rr[1]));
}
__device__ __forceinline__ void pv(f32x16*o,int vb,bf16x8 pa0,bf16x8 pa1,bf16x8 pa2,bf16x8 pa3){
  #pragma unroll
  for(int d0=0;d0<2;++d0){s16x4 lo[4],hi[4];
    #pragma unroll
    for(int ks=0;ks<4;++ks){
      asm volatile("ds_read_b64_tr_b16 %0,%1 offset:%c2":"=&v"(lo[ks]):"v"(vb),"i"(d0*4096+ks*1024):"memory");
      asm volatile("ds_read_b64_tr_b16 %0,%1 offset:%c2":"=&v"(hi[ks]):"v"(vb),"i"(d0*4096+ks*1024+512):"memory");}
    asm volatile("s_waitcnt lgkmcnt(0)":::"memory");SBAR();
    #define PK(k) (bf16x8){lo[k][0],lo[k][1],lo[k][2],lo[k][3],hi[k][0],hi[k][1],hi[k][2],hi[k][3]}
    o[d0]=__builtin_amdgcn_mfma_f32_32x32x16_bf16(pa0,PK(0),o[d0],0,0,0);
    o[d0]=__builtin_amdgcn_mfma_f32_32x32x16_bf16(pa1,PK(1),o[d0],0,0,0);
    o[d0]=__builtin_amdgcn_mfma_f32_32x32x16_bf16(pa2,PK(2),o[d0],0,0,0);
    o[d0]=__builtin_amdgcn_mfma_f32_32x32x16_bf16(pa3,PK(3),o[d0],0,0,0);
    #undef PK
  }
}

#ifndef ATTN_STORE16
#define ATTN_STORE16(p,v) pg8::st16((void*)(p),(v))
#define ATTN_STORE16_PLAIN(p,v) (*(u32x4*)(p)=(v))
#endif
template<int THRL> __device__ __forceinline__ void attn_unit(int b,int h,int qb,const bf16*Q,const bf16*__restrict__ K,const bf16*__restrict__ V,bf16*O,const float*LOGF,char*shm,const int wv,const bool scan){
  const int tid=mk_ltid(wv),lane=tid&63,r32=lane&31,hi=lane>>5; const int wid=__builtin_amdgcn_readfirstlane(tid>>6);
  const long rowbase=(long)b*SEQ; const int q0=qb*QB;
  const bf16*Qw=Q+(rowbase+q0+wid*QBLK)*DM+h*D;
  const bf16*Kh=K+rowbase*DM+h*D,*Vh=V+rowbase*DM+h*D;
  const lds_cptr shm3=(lds_cptr)shm; const unsigned lds0=(unsigned)(uintptr_t)shm;
  float*wsf=(float*)(shm+LDS_WS)+wid*64;
  const bf16*ksrc=Kh+(long)lane*DM+wid*8;
  const bf16*vsrc=Vh+(long)(16*(wid&3)+(lane>>2))*DM+(wid>>2)*32+(lane&3)*8;
  const unsigned kdst=lds0+LDS_K+wid*1024, vdst=lds0+LDS_V+wid*1024;
  #define DMA_K(t,slot) glds16(ksrc+(long)(t)*KVBLK*DM,(unsigned)__builtin_amdgcn_readfirstlane(kdst+(slot)))
  #define DMA_V(t,slot) glds16(vsrc+(long)(t)*KVBLK*DM,(unsigned)__builtin_amdgcn_readfirstlane(vdst+(slot)))
  const int vb0=(int)(lds0+LDS_V)+((lane>>4)&1)*32+(lane&3)*8+(4*hi+((lane&15)>>2))*64;
  const char*Kbase=shm+LDS_K; bf16x8 kf[8];
  const lds_cptr kp0=shm3+LDS_K+hi*1024+r32*16; const lds_cptr vp0=shm3+LDS_V+((lane>>4)&1)*32+(lane&3)*8+(4*hi+((lane&15)>>2))*64;
  const int NT=(q0+QB)/KVBLK;
  if(scan){ typedef __attribute__((address_space(3))) float lf32; typedef float f32x4_t __attribute__((ext_vector_type(4)));
    lf32*cbw=(lf32*)(shm3+LDS_CB); lf32*tot=(lf32*)(shm3+LDS_WS);
    const float*lfp=LOGF+(long)(b*NHEAD+h)*SEQ; const bool act=(4*tid<SEQ);
    f32x4_t v={0.f,0.f,0.f,0.f}; if(act)v=*(const f32x4_t*)(lfp+4*tid);
    v[1]+=v[0];v[2]+=v[1];v[3]+=v[2]; float s=v[3];
    _Pragma("unroll") for(int o=1;o<64;o<<=1){const float n_=__shfl_up(s,o); if(lane>=o)s+=n_;}
    if(lane==63)tot[wid]=s;
    __syncthreads();
    float base=s-v[3]; for(int w=0;w<wid;++w)base+=tot[w];
    if(act)*(__attribute__((address_space(3))) f32x4_t*)(cbw+4*tid)=(f32x4_t){v[0]+base,v[1]+base,v[2]+base,v[3]+base};
    __syncthreads(); }
  DMA_K(0,0);DMA_V(0,0);DMA_K(1,SLOTB);
  bf16x8 qr[4];
  #pragma unroll
  for(int d0=0;d0<4;++d0)qr[d0]=__builtin_nontemporal_load(reinterpret_cast<const bf16x8*>(&Qw[(long)r32*DM+d0*16+hi*8]));
  float mhat=0.f,l_reg=0.f,nm=0.f;f32x16 o[2];o[0]=f32x16{};o[1]=f32x16{};
  typedef float f32x4_t __attribute__((ext_vector_type(4)));
  const __attribute__((address_space(3))) float* cbl=(const __attribute__((address_space(3))) float*)(shm3+LDS_CB)+4*hi;
  #define CBINIT1(C,t,off) do{ const __attribute__((address_space(3))) float* cbt_=cbl+64*(t)+(off); \
    _Pragma("unroll") for(int g_=0;g_<4;++g_){ const f32x4_t b_=*(const __attribute__((address_space(3))) f32x4_t*)(cbt_+8*g_); \
      _Pragma("unroll") for(int j_=0;j_<4;++j_){ C[4*g_+j_]=nm-b_[j_]; } } }while(0)
  #define CBINIT(C0,C1,t) do{ CBINIT1(C0,t,0); CBINIT1(C1,t,32); }while(0)
  const int qrel=wid*QBLK+r32;
  { const float cbq=((const __attribute__((address_space(3))) float*)(shm3+LDS_CB))[q0+qrel]; mhat=-cbq; nm=cbq; }
  #define CMASK(P0,P1,t) do{int jb_=(t)-(NT-4); if(jb_>=0)cmask(P0,P1,jb_,qrel,hi);}while(0)
  bool resc=false;
  #define START(P0,P1) do{ const float rm=rowmax(P0,P1); resc=false; \
    if(__any(rm>(float)THRL)){ const float dl=__builtin_fmaxf(rm,0.f); mhat=fadd_s(mhat,dl); \
      _Pragma("unroll") for(int r=0;r<16;++r){P0[r]=fsub_s(P0[r],dl);P1[r]=fsub_s(P1[r],dl);} \
      nm=-mhat; } \
    _Pragma("unroll") for(int r=0;r<16;++r)P0[r]=__builtin_amdgcn_exp2f(P0[r]); }while(0)
  #define RESC() do{ if(resc){ asm volatile("s_waitcnt lgkmcnt(0)":::"memory"); \
      _Pragma("unroll") for(int d_=0;d_<2;++d_) _Pragma("unroll") for(int r=0;r<16;++r)o[d_][r]*=wsf[crow(r,hi)]; } }while(0)
  f32x16 pA0,pA1,pB0,pB1;
  int sl_prev=0,sl_cur=0,sl_next=SLOTB;
  #define ROT() do{sl_prev=sl_cur;sl_cur=sl_next;sl_next=(sl_next==(NSLOT-1)*SLOTB)?0:sl_next+SLOTB;}while(0)
  DMA_K(2,2*SLOTB);
  WAIT_BAR(3);
  CBINIT(pA0,pA1,0); qkt(pA0,pA1,Kbase,qr,r32,hi);asm volatile("s_nop 15\n\ts_nop 7":"+v"(pA0),"+v"(pA1));CMASK(pA0,pA1,0);
  START(pA0,pA1);
  _Pragma("unroll") for(int r=0;r<16;++r)pA1[r]=__builtin_amdgcn_exp2f(pA1[r]);
  WAIT_BAR(0);
  DMA_K(3,0);DMA_V(1,SLOTB);
  ROT();
  kload8(kf,kp0+sl_cur);
  WAIT_BAR(2);
  s16x4 vlo[8],vhi[8]; u32x4 pw0,pw1,pw2,pw3;
  #define PKW(P,B) cvtpk_s(P[B],P[B+1])
  #define PAF(k) __builtin_bit_cast(bf16x8,pw##k)
  #define VFR(i) (bf16x8){vlo[i][0],vlo[i][1],vlo[i][2],vlo[i][3],vhi[i][0],vhi[i][1],vhi[i][2],vhi[i][3]}
  #define PIN(x) asm volatile("":"+v"(x))
  #define MX3(a,b,c) __builtin_fmaxf(__builtin_fmaxf((a),(b)),(c))
  #define GAPA(MF,A0,A1,A2,A3,W0,W1,PW) do{ MF; sacc+=A0; sacc+=A1; sacc+=A2; sacc+=A3; PIN(sacc); W0; W1; PIN(PW); SBAR(); }while(0)
  #define EX(v) __builtin_amdgcn_exp2f(v)
  #define GAPB(MF,X,B) do{ MF; X[B]=EX(X[B]); X[B+1]=EX(X[B+1]); X[B+2]=EX(X[B+2]); X[B+3]=EX(X[B+3]); PIN(X); SBAR(); }while(0)
  #define VRD(i) do{ vlo[i]=vtr(vp_+(((i)>>2)*4096+((i)&3)*1024)); vhi[i]=vtr(vp_+(((i)>>2)*4096+((i)&3)*1024+512)); }while(0)
  #define KRD(G,j) do{ if(G){ kload2(kf,kp0+sl_next,j); SBAR(); } }while(0)
  #define STEP(C0,C1,P0,P1,t,GK,GV,GL) do{ SBAR(); CBINIT1(C0,t,0); SBAR(); \
    const lds_cptr vp_=vp0+sl_prev; \
    VRD(0); SBAR(); float sacc=(P0[0]+P0[1]); \
    GAPA(C0=__builtin_amdgcn_mfma_f32_32x32x16_bf16(kf[0],qr[0],C0,0,0,0), P0[2],P0[3],P0[4],P0[5],     pw0[0]=PKW(P0,0), pw0[1]=PKW(P0,2), pw0); \
    CBINIT1(C1,t,32); VRD(4); SBAR(); GAPA(C1=__builtin_amdgcn_mfma_f32_32x32x16_bf16(kf[1],qr[0],C1,0,0,0), P0[6],P0[7],P0[8],P0[9],     pw0[2]=PKW(P0,4), pw0[3]=PKW(P0,6), pw0); \
    VRD(1); SBAR(); GAPA(C0=__builtin_amdgcn_mfma_f32_32x32x16_bf16(kf[2],qr[1],C0,0,0,0),   P0[10],P0[11],P0[12],P0[13], pw1[0]=PKW(P0,8), pw1[1]=PKW(P0,10), pw1); \
    VRD(5); SBAR(); GAPA(C1=__builtin_amdgcn_mfma_f32_32x32x16_bf16(kf[3],qr[1],C1,0,0,0),   P0[14],P0[15],P1[0],P1[1],   pw1[2]=PKW(P0,12),pw1[3]=PKW(P0,14), pw1); \
    VRD(2); SBAR(); GAPA(C0=__builtin_amdgcn_mfma_f32_32x32x16_bf16(kf[4],qr[2],C0,0,0,0),   P1[2],P1[3],P1[4],P1[5],     pw2[0]=PKW(P1,0), pw2[1]=PKW(P1,2), pw2); \
    VRD(6); SBAR(); GAPA(C1=__builtin_amdgcn_mfma_f32_32x32x16_bf16(kf[5],qr[2],C1,0,0,0),   P1[6],P1[7],P1[8],P1[9],     pw2[2]=PKW(P1,4), pw2[3]=PKW(P1,6), pw2); \
    VRD(3); SBAR(); GAPA(C0=__builtin_amdgcn_mfma_f32_32x32x16_bf16(kf[6],qr[3],C0,0,0,0),   P1[10],P1[11],P1[12],P1[13], pw3[0]=PKW(P1,8), pw3[1]=PKW(P1,10), pw3); \
    VRD(7); SBAR(); GAPA(C1=__builtin_amdgcn_mfma_f32_32x32x16_bf16(kf[7],qr[3],C1,0,0,0),   P1[14],P1[15],0.f,0.f,       pw3[2]=PKW(P1,12),pw3[3]=PKW(P1,14), pw3); \
    l_reg+=sacc; \
    if(GK){DMA_K((t)+3,sl_cur);} if(GV){DMA_V((t)+1,sl_next);} \
    CMASK(C0,C1,t); \
    { float a=MX3(C0[0],C0[1],C1[0]),b=MX3(C0[2],C0[3],C1[1]); a=MX3(a,C1[2],C1[3]); \
      _Pragma("unroll") for(int r=4;r<16;r+=4){a=MX3(a,C0[r],C0[r+1]);b=MX3(b,C0[r+2],C0[r+3]);a=MX3(a,C1[r],C1[r+1]);b=MX3(b,C1[r+2],C1[r+3]);} \
      float rm=__builtin_fmaxf(a,b); { auto rr=__builtin_amdgcn_permlane32_swap(__float_as_uint(rm),__float_as_uint(rm),false,false); rm=__builtin_fmaxf(__uint_as_float(rr[0]),__uint_as_float(rr[1])); } \
      resc=false; \
      if(__builtin_expect(__any(rm>(float)THRL),0)){ const float dl=__builtin_fmaxf(rm,0.f); mhat+=dl; \
        _Pragma("unroll") for(int r=0;r<16;++r){C0[r]-=dl;C1[r]-=dl;} \
        nm=-mhat; \
        const float f=__builtin_amdgcn_exp2f(-dl); l_reg*=f; if(hi==0)wsf[r32]=f; resc=true; } } \
    SBAR(); \
    GAPB(o[0]=__builtin_amdgcn_mfma_f32_32x32x16_bf16(PAF(0),VFR(0),o[0],0,0,0), C0,0); \
    GAPB(o[1]=__builtin_amdgcn_mfma_f32_32x32x16_bf16(PAF(0),VFR(4),o[1],0,0,0), C0,4); \
    KRD(GL,0); GAPB(o[0]=__builtin_amdgcn_mfma_f32_32x32x16_bf16(PAF(1),VFR(1),o[0],0,0,0), C0,8); \
    KRD(GL,1); GAPB(o[1]=__builtin_amdgcn_mfma_f32_32x32x16_bf16(PAF(1),VFR(5),o[1],0,0,0), C0,12); \
    KRD(GL,2); GAPB(o[0]=__builtin_amdgcn_mfma_f32_32x32x16_bf16(PAF(2),VFR(2),o[0],0,0,0), C1,0); \
    KRD(GL,3); GAPB(o[1]=__builtin_amdgcn_mfma_f32_32x32x16_bf16(PAF(2),VFR(6),o[1],0,0,0), C1,4); \
    GAPB(o[0]=__builtin_amdgcn_mfma_f32_32x32x16_bf16(PAF(3),VFR(3),o[0],0,0,0), C1,8); \
    GAPB(o[1]=__builtin_amdgcn_mfma_f32_32x32x16_bf16(PAF(3),VFR(7),o[1],0,0,0), C1,12); \
    }while(0)
  int t=1;
  #undef CMASK
  #define CMASK(P0,P1,t) do{}while(0)
  for(;t+5<NT;t+=2){
    STEP(pB0,pB1,pA0,pA1,t,true,true,true);     WAIT_BAR(2); RESC(); ROT();
    STEP(pA0,pA1,pB0,pB1,t+1,true,true,true);   WAIT_BAR(2); RESC(); ROT();
  }
  #undef CMASK
  #define CMASK(P0,P1,t) do{int jb_=(t)-(NT-4); if(jb_>=0)cmask(P0,P1,jb_,qrel,hi);}while(0)
  #define ENDW(tt) do{ if((tt)+3<NT){WAIT_BAR(2);} else if((tt)+2<NT){WAIT_BAR(1);} else {WAIT_BAR(0);} }while(0)
  for(;t+1<NT;t+=2){
    STEP(pB0,pB1,pA0,pA1,t,(t+3<NT),(t+1<NT),(t+1<NT));       ENDW(t);   RESC(); ROT();
    STEP(pA0,pA1,pB0,pB1,t+1,(t+4<NT),(t+2<NT),(t+2<NT));     ENDW(t+1); RESC(); ROT();
  }
  STEP(pB0,pB1,pA0,pA1,NT-1,false,false,false); RESC();
  { float sacc=pB0[0]+pB0[1]; _Pragma("unroll") for(int r=2;r<16;++r)sacc+=pB0[r]; _Pragma("unroll") for(int r=0;r<16;++r)sacc+=pB1[r]; l_reg+=sacc;
    pw0=(u32x4){PKW(pB0,0),PKW(pB0,2),PKW(pB0,4),PKW(pB0,6)};pw1=(u32x4){PKW(pB0,8),PKW(pB0,10),PKW(pB0,12),PKW(pB0,14)};pw2=(u32x4){PKW(pB1,0),PKW(pB1,2),PKW(pB1,4),PKW(pB1,6)};pw3=(u32x4){PKW(pB1,8),PKW(pB1,10),PKW(pB1,12),PKW(pB1,14)};
    SBAR(); pv(o,vb0+sl_cur,PAF(0),PAF(1),PAF(2),PAF(3)); }
  #undef PKW
  #undef PAF
  #undef VFR
  #undef PIN
  #undef MX3
  #undef GAPA
  #undef GAPB
  #undef EX
  #undef VRD
  #undef KRD
  #undef STEP
  #undef ENDW
  {auto rr=__builtin_amdgcn_permlane32_swap(__float_as_uint(l_reg),__float_as_uint(l_reg),false,false);l_reg=__uint_as_float(rr[0])+__uint_as_float(rr[1]);}
  if(hi==0)wsf[32+r32]=l_reg;asm volatile("s_waitcnt lgkmcnt(0)":::"memory");
  float rli[16];
  #pragma unroll
  for(int r=0;r<16;++r)rli[r]=__builtin_amdgcn_rcpf(wsf[32+crow(r,hi)]);
  bf16*Ow=O+(rowbase+q0+wid*QBLK)*DM+h*D;
  { bf16*stg=(bf16*)(shm+LDS_OST)+wid*2048;
    #pragma unroll
    for(int r=0;r<16;++r){const int orow=crow(r,hi);
      #pragma unroll
      for(int d0=0;d0<2;++d0)stg[orow*64+d0*32+r32]=__float2bfloat16(o[d0][r]*rli[r]);}
    asm volatile("s_waitcnt lgkmcnt(0)":::"memory");
    #pragma unroll
    for(int i=0;i<4;++i){const int row=i*8+(lane>>3),ch=lane&7; const u32x4 v=*(const u32x4*)(stg+row*64+ch*8); ATTN_STORE16(Ow+(long)row*DM+ch*8,v);} }
  asm volatile("s_waitcnt lgkmcnt(0)\n\ts_barrier":::"memory");
  #undef DMA_K
  #undef DMA_V
  #undef CMASK
  #undef START
  #undef RESC
  #undef ROT
  #undef CBINIT
  #undef CBINIT1
}
constexpr int ATTN_LDS_BYTES=LDS_BYTES;
struct AttnTensors { const bf16* Q; const bf16* K; const bf16* V; bf16* O; const float* LOGF; };
struct AttnUnit { int bh; int qb; };
struct StaticOrder {
  int vcu,G;
  __device__ __forceinline__ explicit StaticOrder(int grid,int block):vcu((grid%8==0)?(block%8)*(grid/8)+block/8:block),G(grid){}
  __device__ __forceinline__ bool next(int i,AttnUnit&u)const{
    if(G==256){ if(i>=4)return false; const int s=vcu&1; u.bh=vcu>>1; u.qb=(i==0)?7-s:(i==1)?s:(i==2)?4+s:3-s; return true; }
    const int idx=vcu+i*G; if(idx>=BATCH*NHEAD*NQB)return false; u.bh=idx/NQB; u.qb=NQB-1-(idx%NQB); return true; }
  __device__ __forceinline__ void a_ready(const AttnUnit&)const{}
  __device__ __forceinline__ void done(const AttnUnit&)const{}
};
template<class Sched,int THRL=8> __device__ __forceinline__ void attn_phase(char*lds,const AttnTensors&T,const Sched&S,const int wv){
  AttnUnit u;
  int last_bh=-1;
  for(int i=0;S.next(i,u);++i){ S.a_ready(u); attn_unit<THRL>(u.bh/NHEAD,u.bh%NHEAD,u.qb,T.Q,T.K,T.V,T.O,T.LOGF,lds,wv,u.bh!=last_bh); last_bh=u.bh; S.done(u); }
}
#undef SBAR
#undef WAIT_BAR
}

namespace cg = cooperative_groups;
constexpr int NWAVES = 8;
constexpr int BATCH = 8, SEQ = 2048, D = 1024, M = BATCH * SEQ, DEPTH = 4, DFF = 2816;
constexpr float EPS = 1e-6f, LOG2E = 1.4426950408889634f;
constexpr size_t MiB = 1u << 20;
constexpr size_t WS_SSQ = 1 * MiB;
constexpr size_t WS_LOGF = 2 * MiB;
constexpr size_t WS_IG = 3 * MiB, WS_LF = 3 * MiB + 512 * 1024;
constexpr size_t WS_NS = 4 * MiB;
constexpr size_t WS_MS = 5 * MiB;
constexpr size_t WS_LNP = 6 * MiB;
constexpr size_t WS_WG = 10 * MiB;
constexpr size_t WS_WM = 10 * MiB + 512 * 1024;
constexpr size_t WS_W = 12 * MiB;
constexpr size_t W_AIN = 0, W_AOUT = 12 * MiB, W_BIN = 16 * MiB, W_BOUT = 24 * MiB, W_CIN = 26 * MiB, W_COUT = 34 * MiB, W_GU = 38 * MiB, W_DN = 82 * MiB;
constexpr size_t SZ_AIN = 6 * MiB, SZ_AOUT = 2 * MiB, SZ_GU = 11 * MiB, SZ_DN = (size_t)1024 * 2816 * 2;
constexpr size_t WS_XB = 116 * MiB;
constexpr size_t WS_S1 = 148 * MiB, WS_S2 = 180 * MiB;
constexpr size_t WS_PROJ = 212 * MiB;
constexpr size_t WS_END = 340 * MiB;
constexpr int LDSCTL_OFF = 131072;
constexpr int CW_BAR = 4096;
constexpr size_t CTL_ZERO_BYTES = 64 * 1024;
constexpr int LDS_BYTES = 147456;

#define LAS __attribute__((address_space(3)))
typedef unsigned short bf16;
typedef float f32x4 __attribute__((ext_vector_type(4)));
typedef float f32x2 __attribute__((ext_vector_type(2)));
typedef float f32x16 __attribute__((ext_vector_type(16)));
typedef short bf16x8 __attribute__((ext_vector_type(8)));
typedef unsigned u32x4 __attribute__((ext_vector_type(4)));
typedef unsigned u32x2 __attribute__((ext_vector_type(2)));
typedef LAS unsigned char* ldsp;
__device__ __forceinline__ unsigned pk2(float lo, float hi) { return pg8::pkbf(lo, hi); }
__device__ __forceinline__ float bf2f(unsigned short h) { return __uint_as_float((unsigned)h << 16); }
__device__ __forceinline__ float bflo(unsigned w) { return __uint_as_float(w << 16); }
__device__ __forceinline__ float bfhi(unsigned w) { return __uint_as_float(w & 0xffff0000u); }
__device__ __forceinline__ float wave_sum(float v) {
#pragma unroll
    for (int o = 1; o < 64; o <<= 1) v += __shfl_xor(v, o);
    return v;
}
__device__ __forceinline__ float log_sigmoid(float x) { return fminf(x, 0.f) - log1pf(expf(-fabsf(x))); }
__device__ __forceinline__ float sigmoid_f(float x) { return __builtin_amdgcn_rcpf(1.0f + __builtin_amdgcn_exp2f(-LOG2E * x)); }
__device__ __forceinline__ float exp_f(float x) { return __builtin_amdgcn_exp2f(LOG2E * x); }
#define LDS_BARRIER() asm volatile("s_waitcnt lgkmcnt(0)\n\ts_barrier" ::: "memory")
#define MFMA32(a, b, c) __builtin_amdgcn_mfma_f32_32x32x16_bf16(a, b, c, 0, 0, 0)

#define XB_TMO      128
#define XB_XCNT(j)  (256  + 64 * (j))
#define XB_XSUB(j)  (1280 + 64 * (j))
#define XB_XGEN(j)  (2304 + 64 * (j))
#define XB_TOP      3328
#define XB_TOPGEN   3392
#define XCD_BAR_WORDS 3456
#define XB_SPIN_CAP (1u << 18)

__device__ __forceinline__ unsigned xb_ld(unsigned* p)              { return __hip_atomic_load(p, __ATOMIC_RELAXED, __HIP_MEMORY_SCOPE_AGENT); }
__device__ __forceinline__ unsigned xb_add(unsigned* p, unsigned v) { return __hip_atomic_fetch_add(p, v, __ATOMIC_RELAXED, __HIP_MEMORY_SCOPE_AGENT); }
__device__ __forceinline__ unsigned xb_xcc_id() { return (unsigned)__builtin_amdgcn_s_getreg((3 << 11) | 20) & 0xFu; }
#define XB_SPIN(cond, bar) do { unsigned _sp = 0; while (cond) { __builtin_amdgcn_s_sleep(1); \
    if ((++_sp & 255u) == 0u) { if (xb_ld(&(bar)[XB_TMO])) break; if (_sp > XB_SPIN_CAP) { atomicAdd(&(bar)[XB_TMO], 1u); break; } } } } while (0)

struct XcdBarrier {
    unsigned* bar; unsigned x;
    volatile LAS unsigned* st;
};

__device__ __forceinline__ XcdBarrier xcd_barrier_post(unsigned* bar, volatile LAS unsigned* st, int tid) {
    XcdBarrier b; b.bar = bar; b.x = xb_xcc_id(); b.st = st;
    if (tid == 0) (void)xb_add(&bar[XB_XCNT(b.x)], 1u);
    return b;
}
__device__ __forceinline__ void xcd_barrier_complete(unsigned* bar, unsigned x, unsigned& nloc, unsigned& nx) {
    const unsigned G = gridDim.x * gridDim.y * gridDim.z;
    unsigned sum, cnt, mine, sp = 0u;
    for (;;) {
        sum = 0u; cnt = 0u; mine = 0u;
#pragma unroll
        for (unsigned j = 0; j < 16; ++j) { const unsigned c = xb_ld(&bar[XB_XCNT(j)]); sum += c; cnt += (c > 0u) ? 1u : 0u; mine = (j == x) ? c : mine; }
        if (sum == G) break;
        __builtin_amdgcn_s_sleep(1);
        if ((++sp & 255u) == 0u) { if (xb_ld(&bar[XB_TMO])) break; if (sp > XB_SPIN_CAP) { atomicAdd(&bar[XB_TMO], 1u); break; } }
    }
    nloc = mine > 0u ? mine : 1u; nx = cnt > 0u ? cnt : 1u;
}

__device__ __forceinline__ void xcd_barrier(const XcdBarrier& b, int tid) {
    asm volatile("s_waitcnt vmcnt(0)" ::: "memory");
    __syncthreads();
    if (tid == 0) {
        unsigned* bar = b.bar;
        __builtin_amdgcn_s_waitcnt(0);
        unsigned nloc = b.st[0], nx = b.st[1];
        if (nloc == 0u) { xcd_barrier_complete(bar, b.x, nloc, nx); b.st[0] = nloc; b.st[1] = nx; }
        const unsigned old = xb_add(&bar[XB_XSUB(b.x)], 1u);
        const unsigned gen = old / nloc;
        if (old + 1u == (gen + 1u) * nloc) {
            __builtin_amdgcn_fence(__ATOMIC_RELEASE, "agent");
            asm volatile("s_waitcnt vmcnt(0)" ::: "memory");
            const unsigned og = xb_add(&bar[XB_TOP], 1u);
            const unsigned tg = og / nx;
            if (og + 1u == (tg + 1u) * nx) xb_add(&bar[XB_TOPGEN], 1u);
            else XB_SPIN(xb_ld(&bar[XB_TOPGEN]) == tg, bar);
            __builtin_amdgcn_fence(__ATOMIC_ACQUIRE, "agent");
            xb_add(&bar[XB_XGEN(b.x)], 1u);
            asm volatile("s_waitcnt vmcnt(0)" ::: "memory");
        } else {
            XB_SPIN(xb_ld(&bar[XB_XGEN(b.x)]) == gen, bar);
            __builtin_amdgcn_fence(__ATOMIC_ACQUIRE, "agent");
            asm volatile("s_waitcnt vmcnt(0)" ::: "memory");
        }
    }
    __syncthreads();
}

struct Frame {
    ldsp lds; int tid, lane, wave, vcu, G;
    const float* const* inp; float* out; unsigned char* ws;
    __device__ __forceinline__ const float* in_(int i) const { asm volatile("" : "+s"(i)); return inp[i]; }
};

struct P0Job { const float* W; const float* gain; bf16* WT; int ldw, K, n0, dst, kb; };
__device__ __forceinline__ void p0_set(P0Job& j, const float* W, int ldw, int K, int N, bf16* WT, const float* gain, int r, bool gu) {
    const int nblk = N / 32, kb = r / nblk, nb = r % nblk; const int n0 = 32 * nb; int dst = n0;
    if (gu) { if (n0 < DFF) dst = 256 * (n0 / 128) + (n0 % 128); else { const int n1 = n0 - DFF; dst = 256 * (n1 / 128) + 128 + (n1 % 128); } }
    j.W = W; j.gain = gain; j.WT = WT; j.ldw = ldw; j.K = K; j.n0 = n0; j.dst = dst; j.kb = kb;
}
constexpr int P0_I_AIN = 16 * 96, P0_I_SQ = 16 * 32, P0_I_BIN = 16 * 128, P0_I_COUT = 32 * 32, P0_I_GU = 16 * 176, P0_I_DN = 44 * 32;
constexpr int P0_MIX = 2 * P0_I_AIN + 2 * P0_I_SQ + P0_I_BIN + P0_I_SQ + P0_I_BIN + P0_I_COUT, P0_FFN = P0_I_GU + P0_I_DN;
__device__ __forceinline__ void p0_decode(Frame& F, int it, P0Job& j, int mode, bool all_ffn) {
    bf16* WB = (bf16*)(F.ws + WS_W); const float* n1g = F.in_(1); const float* n2g = F.in_(2);
    constexpr int I_AIN = P0_I_AIN, I_SQ = P0_I_SQ, I_BIN = P0_I_BIN, I_GU = P0_I_GU, I_DN = P0_I_DN;
    int r = it;
    if (mode > 0) { const int i = mode;
        if (r < I_GU) { p0_set(j, F.in_(20) + (size_t)i * D * 2 * DFF, 2 * DFF, D, 2 * DFF, (bf16*)((char*)WB + W_GU + i * SZ_GU), n2g + i * D, r, true); return; } r -= I_GU;
        p0_set(j, F.in_(21) + (size_t)i * DFF * D, D, DFF, D, (bf16*)((char*)WB + W_DN + i * SZ_DN), nullptr, r, false); return; }
    const int nf = all_ffn ? 4 : 1;
    if (r < nf * I_GU) { const int i = r / I_GU; p0_set(j, F.in_(20) + (size_t)i * D * 2 * DFF, 2 * DFF, D, 2 * DFF, (bf16*)((char*)WB + W_GU + i * SZ_GU), n2g + i * D, r % I_GU, true); return; } r -= nf * I_GU;
    if (r < nf * I_DN) { const int i = r / I_DN; p0_set(j, F.in_(21) + (size_t)i * DFF * D, D, DFF, D, (bf16*)((char*)WB + W_DN + i * SZ_DN), nullptr, r % I_DN, false); return; } r -= nf * I_DN;
    if (r < 2 * I_AIN) { const int i = r / I_AIN; p0_set(j, F.in_(4) + (size_t)i * D * 3088, 3088, D, 3072, (bf16*)((char*)WB + W_AIN + i * SZ_AIN), n1g + (3 * i) * D, r % I_AIN, false); return; } r -= 2 * I_AIN;
    if (r < 2 * I_SQ) { const int i = r / I_SQ; p0_set(j, F.in_(6) + (size_t)i * D * D, D, D, D, (bf16*)((char*)WB + W_AOUT + i * SZ_AOUT), nullptr, r % I_SQ, false); return; } r -= 2 * I_SQ;
    if (r < I_BIN) { p0_set(j, F.in_(7), 4112, D, 4096, (bf16*)((char*)WB + W_BIN), n1g + 1 * D, r, false); return; } r -= I_BIN;
    if (r < I_SQ) { p0_set(j, F.in_(13), D, D, D, (bf16*)((char*)WB + W_BOUT), nullptr, r, false); return; } r -= I_SQ;
    if (r < I_BIN) { p0_set(j, F.in_(14), 4096, D, 4096, (bf16*)((char*)WB + W_CIN), n1g + 2 * D, r, false); return; } r -= I_BIN;
    p0_set(j, F.in_(19), D, 2048, D, (bf16*)((char*)WB + W_COUT), nullptr, r, false);
}
__device__ __forceinline__ void p0_load(const P0Job& j, int lane, f32x4 (&w)[8]) {
    const int kr = lane >> 3, n4 = (lane & 7) * 4;
#pragma unroll
    for (int i = 0; i < 8; ++i) w[i] = __builtin_nontemporal_load((const f32x4*)(j.W + (size_t)(64 * j.kb + 8 * i + kr) * j.ldw + j.n0 + n4));
}
__device__ __forceinline__ void p0_finish(const P0Job& j, int lane, const f32x4 (&w)[8], LAS float* scr) {
    const int k0 = 64 * j.kb, kr = lane >> 3, n4 = (lane & 7) * 4;
#pragma unroll
    for (int i = 0; i < 8; ++i) { const float gk = j.gain ? j.gain[k0 + 8 * i + kr] : 1.0f; LAS float* sp = scr + (8 * i + kr) * 33 + n4; sp[0] = w[i][0] * gk; sp[1] = w[i][1] * gk; sp[2] = w[i][2] * gk; sp[3] = w[i][3] * gk; }
    asm volatile("s_waitcnt lgkmcnt(0)" ::: "memory");
    const int c = lane & 7;
#pragma unroll
    for (int jj = 0; jj < 4; ++jj) { const int n = (lane >> 3) + 8 * jj; const LAS float* s = scr + (8 * c) * 33 + n;
        u32x4 o; o.x = pk2(s[0 * 33], s[1 * 33]); o.y = pk2(s[2 * 33], s[3 * 33]); o.z = pk2(s[4 * 33], s[5 * 33]); o.w = pk2(s[6 * 33], s[7 * 33]);
        pg8::st16(j.WT + (size_t)(j.dst + n) * j.K + k0 + 8 * c, o); }
    asm volatile("s_waitcnt lgkmcnt(0)" ::: "memory");
}
__device__ __forceinline__ void p0_convert(Frame& F, int mode, bool all_ffn, int gw, int NGW, int nitems) {
    LAS float* scr = (LAS float*)(F.lds + F.wave * 16384); const int lane = F.lane;
    if (gw < nitems) {
        int it = gw; P0Job j0; f32x4 w0[8]; p0_decode(F, it, j0, mode, all_ffn); p0_load(j0, lane, w0);
        for (;;) { const int nx = it + NGW; const bool has = nx < nitems; P0Job j1 = j0; f32x4 w1[8];
            if (has) { p0_decode(F, nx, j1, mode, all_ffn); p0_load(j1, lane, w1); }
            p0_finish(j0, lane, w0, scr);
            if (!has) break;
            j0 = j1; it = nx;
#pragma unroll
            for (int i = 0; i < 8; ++i) w0[i] = w1[i]; }
    }
}
__device__ __forceinline__ void p0_prologue(Frame& F) {
    const int gw = F.vcu * NWAVES + F.wave, NGW = F.G * NWAVES, lane = F.lane;
    const float* n1g = F.in_(1);
    const bool all_ffn = (F.G != 256);
    p0_convert(F, -1, all_ffn, gw, NGW, P0_MIX + (all_ffn ? 4 : 1) * P0_FFN);
    { bf16* WG = (bf16*)(F.ws + WS_WG); const int gt = blockIdx.x * (NWAVES * 64) + F.tid, NT = F.G * NWAVES * 64;
      for (int e = gt; e < 3 * 16 * 1024; e += NT) { const int g = e / 16384, n = (e >> 10) & 15, k = e & 1023;
          const float* W = (g < 2) ? F.in_(4) + (size_t)g * D * 3088 : F.in_(7); const int ldw = (g < 2) ? 3088 : 4112, c0 = (g < 2) ? 3072 : 4096;
          const float gn = n1g[((g < 2) ? 3 * g : 1) * D + k];
          WG[e] = (bf16)(pk2(W[(size_t)k * ldw + c0 + n] * gn, 0.f) & 0xffffu); }
      bf16* WM = (bf16*)(F.ws + WS_WM);
      for (int e = gt; e < 8 * 128 * 128; e += NT) { const int t = (e >> 7) & 127, s = e & 127; WM[e] = (bf16)(((t >> 6) >= (s >> 6)) ? (pk2(F.in_(17)[e], 0.f) & 0xffffu) : 0u); } }
    { float* ssq = (float*)(F.ws + WS_SSQ); bf16* XB = (bf16*)(F.ws + WS_XB);
      for (int m = gw; m < M; m += NGW) {
          const f32x4* xr = (const f32x4*)(F.in_(0) + (size_t)m * D) + lane;
          unsigned long long* o8 = (unsigned long long*)(XB + (size_t)m * D) + lane; float s = 0.f;
#pragma unroll
          for (int j = 0; j < 4; ++j) { const f32x4 v = __builtin_nontemporal_load(xr + 64 * j); const unsigned w0 = pk2(v[0], v[1]), w1 = pk2(v[2], v[3]);
              s += (bflo(w0) * bflo(w0) + bfhi(w0) * bfhi(w0)) + (bflo(w1) * bflo(w1) + bfhi(w1) * bfhi(w1));
              o8[64 * j] = (unsigned long long)w0 | ((unsigned long long)w1 << 32); }
          s = wave_sum(s);
          if (lane < 16) ssq[(size_t)m * 16 + lane] = (lane == 0) ? s : 0.f; } }
}


constexpr int RS_OFF = LDSCTL_OFF + 1024;
__device__ __forceinline__ void fill_rstd(Frame& F, const pg8::StaticOrder& S, const float* ssq) {
    LAS float* RS = (LAS float*)(F.lds + RS_OFF); pg8::Unit u;
    for (int i = 0; S.next(i, u); ++i) if (F.tid < 256) { const f32x4* sp = (const f32x4*)(ssq + (size_t)(u.pm * 256 + F.tid) * 16); const f32x4 s0 = sp[0], s1 = sp[1], s2 = sp[2], s3 = sp[3];
        const float ss = ((s0[0] + s0[1]) + (s0[2] + s0[3])) + ((s1[0] + s1[1]) + (s1[2] + s1[3])) + ((s2[0] + s2[1]) + (s2[2] + s2[3])) + ((s3[0] + s3[1]) + (s3[2] + s3[3]));
        RS[i * 256 + F.tid] = 1.0f / sqrtf(ss * (1.0f / 1024.0f) + EPS); }
    __syncthreads();
}

struct RstdPre {
    const pg8::StaticOrder* S; const float* ssq; LAS float* RS; f32x4 v[3][4]; int nu;
    __device__ __forceinline__ void issue(int tid) { pg8::Unit u; nu = 0;
#pragma unroll
        for (int k = 0; k < 3; ++k) { const int i = 2 * k + (tid >> 8); if (S->next(i, u)) { const f32x4* sp = (const f32x4*)(ssq + (size_t)(u.pm * 256 + (tid & 255)) * 16); v[k][0] = sp[0]; v[k][1] = sp[1]; v[k][2] = sp[2]; v[k][3] = sp[3]; nu = k + 1; } } }
    __device__ __forceinline__ void finish(int tid) {
#pragma unroll
        for (int k = 0; k < 3; ++k) if (k < nu) { const f32x4 s0 = v[k][0], s1 = v[k][1], s2 = v[k][2], s3 = v[k][3];
            const float ss = ((s0[0] + s0[1]) + (s0[2] + s0[3])) + ((s1[0] + s1[1]) + (s1[2] + s1[3])) + ((s2[0] + s2[1]) + (s2[2] + s2[3])) + ((s3[0] + s3[1]) + (s3[2] + s3[3]));
            RS[(2 * k + (tid >> 8)) * 256 + (tid & 255)] = 1.0f / sqrtf(ss * (1.0f / 1024.0f) + EPS); } }
};
template <int KIND>
__device__ __forceinline__ void gate_items(Frame& F, const bf16* XB, const bf16* WG, const float* ssq, const float* bias0, const float* bias1, float* out0, float* out1) {
    const int lane = F.lane, wq = F.wave & 3, kh = F.wave >> 2; LAS f32x4* XS = (LAS f32x4*)F.lds;
    for (int it0 = 0; it0 < M / 16; it0 += 4 * F.G) {
        const int it = it0 + wq * F.G + F.vcu; const bool live = it < M / 16; const int row0 = (live ? it : 0) * 16;
        const bf16* ap = XB + (size_t)(row0 + (lane & 15)) * D + kh * 512 + (lane >> 4) * 8; const bf16* bp = WG + (size_t)(lane & 15) * D + kh * 512 + (lane >> 4) * 8;
        f32x4 acc = {0.f, 0.f, 0.f, 0.f};
#pragma unroll
        for (int ks = 0; ks < 16; ++ks) { const bf16x8 a = *(const bf16x8*)(ap + ks * 32), b = *(const bf16x8*)(bp + ks * 32); acc = __builtin_amdgcn_mfma_f32_16x16x32_bf16(a, b, acc, 0, 0, 0); }
        if (kh == 1) XS[wq * 64 + lane] = acc;
        __syncthreads();
        if (kh == 0 && live) {
            acc += XS[wq * 64 + lane];
            const int g = lane & 15, t0 = row0 + (lane >> 4) * 4, b = t0 / SEQ, s = t0 % SEQ;
            f32x4 val;
#pragma unroll
            for (int r = 0; r < 4; ++r) { const f32x4* sp = (const f32x4*)(ssq + (size_t)(t0 + r) * 16); const f32x4 s0 = sp[0], s1 = sp[1], s2 = sp[2], s3 = sp[3];
                const float ss = ((s0[0] + s0[1]) + (s0[2] + s0[3])) + ((s1[0] + s1[1]) + (s1[2] + s1[3])) + ((s2[0] + s2[1]) + (s2[2] + s2[3])) + ((s3[0] + s3[1]) + (s3[2] + s3[3]));
                const float f = acc[r] * (1.0f / sqrtf(ss * (1.0f / 1024.0f) + EPS));
                if (KIND == 0) val[r] = LOG2E * log_sigmoid(f + bias0[g]);
                else val[r] = (g < 8) ? f + bias0[g] : log_sigmoid(f + bias1[g - 8]); }
            if (KIND == 0) *(f32x4*)(out0 + (size_t)(b * 16 + g) * SEQ + s) = val;
            else { if (g < 8) *(f32x4*)(out0 + (size_t)(b * 8 + g) * SEQ + s) = val; else *(f32x4*)(out1 + (size_t)(b * 8 + g - 8) * SEQ + s) = val; }
        }
        __syncthreads();
    }
}

typedef short s16x4 __attribute__((ext_vector_type(4)));
__device__ __forceinline__ s16x4 tr16(const LAS unsigned char* p) { return __builtin_bit_cast(s16x4, __builtin_amdgcn_ds_read_tr16_b64_v4i16((LAS s16x4*)p)); }
__device__ __forceinline__ bf16x8 tr_frag(const LAS unsigned char* base, int pitch, int lane) {
    const LAS unsigned char* p = base + (8 * (lane >> 5) + ((lane & 15) >> 2)) * pitch + (16 * ((lane >> 4) & 1) + 4 * (lane & 3)) * 2;
    const s16x4 lo = tr16(p), hi = tr16(p + 4 * pitch); return (bf16x8){lo[0], lo[1], lo[2], lo[3], hi[0], hi[1], hi[2], hi[3]};
}
__device__ __forceinline__ void conv_silu8(const bf16* proj, int b, int t, int col, const float* cw, const float* cb, float scale, float (&o)[8]) {
    const f32x4 b0 = *(const f32x4*)(cb + col), b1 = *(const f32x4*)(cb + col + 4);
    float a[8] = {b0[0], b0[1], b0[2], b0[3], b1[0], b1[1], b1[2], b1[3]};
#pragma unroll
    for (int j = 0; j < 4; ++j) { const int tt = t - 3 + j;
        if (tt >= 0) { const u32x4 x = *(const u32x4*)(proj + (size_t)(b * SEQ + tt) * 4096 + col); const f32x4 w0 = *(const f32x4*)(cw + j * 2048 + col), w1 = *(const f32x4*)(cw + j * 2048 + col + 4);
            a[0] += w0[0] * bflo(x.x); a[1] += w0[1] * bfhi(x.x); a[2] += w0[2] * bflo(x.y); a[3] += w0[3] * bfhi(x.y);
            a[4] += w1[0] * bflo(x.z); a[5] += w1[1] * bfhi(x.z); a[6] += w1[2] * bflo(x.w); a[7] += w1[3] * bfhi(x.w); } }
#pragma unroll
    for (int i = 0; i < 8; ++i) o[i] = a[i] * __builtin_amdgcn_rcpf(1.0f + __builtin_amdgcn_exp2f(-LOG2E * a[i])) * scale;
}
template <int CTRL> __device__ __forceinline__ float dpp_mov(float v) { return __builtin_bit_cast(float, __builtin_amdgcn_update_dpp(0, __builtin_bit_cast(int, v), CTRL, 0xf, 0xf, false)); }
__device__ __forceinline__ float wave_scan_add(float v, int lane) {
    const int rl = lane & 15; float t;
    t = dpp_mov<0x111>(v); v = (rl >= 1) ? v + t : v;
    t = dpp_mov<0x112>(v); v = (rl >= 2) ? v + t : v;
    t = dpp_mov<0x114>(v); v = (rl >= 4) ? v + t : v;
    t = dpp_mov<0x118>(v); v = (rl >= 8) ? v + t : v;
    t = dpp_mov<0x142>(v); v = ((lane & 31) >= 16) ? v + t : v;
    t = dpp_mov<0x143>(v); v = (lane >= 32) ? v + t : v;
    return v;
}
__device__ __forceinline__ float wave_scan_max(float v, int lane) {
    const int rl = lane & 15; float t;
    t = dpp_mov<0x111>(v); v = (rl >= 1) ? fmaxf(v, t) : v;
    t = dpp_mov<0x112>(v); v = (rl >= 2) ? fmaxf(v, t) : v;
    t = dpp_mov<0x114>(v); v = (rl >= 4) ? fmaxf(v, t) : v;
    t = dpp_mov<0x118>(v); v = (rl >= 8) ? fmaxf(v, t) : v;
    t = dpp_mov<0x142>(v); v = ((lane & 31) >= 16) ? fmaxf(v, t) : v;
    t = dpp_mov<0x143>(v); v = (lane >= 32) ? fmaxf(v, t) : v;
    return v;
}
__device__ __forceinline__ float lane63(float v) { return __builtin_bit_cast(float, __builtin_amdgcn_readlane(__builtin_bit_cast(int, v), 63)); }
__device__ __forceinline__ float wave_max(float v, int lane) { return lane63(wave_scan_max(v, lane)); }
constexpr int PA_KS = 0, PA_KSB = 64 * 40 * 2, PA_VS = 2 * PA_KSB, PA_VSB = 64 * 136 * 2;
__device__ __forceinline__ void mlstm_pass_a(Frame& F, const bf16* proj, const float* IG, const float* LF, const float* cw, const float* cb, bf16* CST, float* NS, float* MS) {
    const int tid = F.tid, lane = F.lane, wave = F.wave, r32 = lane & 31, hh = lane >> 5;
    for (int u = F.vcu; u < 256; u += F.G) {
        const int bh = u >> 2, ds = u & 3, b = bh >> 3, h = bh & 7;
        const int dg = tid & 3, sk = (tid >> 2) & 63, colk = 1024 + h * 128 + ds * 32 + dg * 8;
        const int eg = tid & 15, s0 = tid >> 4, colv = 2048 + h * 128 + eg * 8;
        float wt[4][8], bs8[8];
        { const f32x4 b0 = *(const f32x4*)(cb + colk), b1 = *(const f32x4*)(cb + colk + 4);
#pragma unroll
          for (int i = 0; i < 4; ++i) { bs8[i] = b0[i]; bs8[4 + i] = b1[i]; }
#pragma unroll
          for (int j = 0; j < 4; ++j) { const f32x4 w0 = *(const f32x4*)(cw + j * 2048 + colk), w1 = *(const f32x4*)(cw + j * 2048 + colk + 4);
#pragma unroll
              for (int i = 0; i < 4; ++i) { wt[j][i] = w0[i]; wt[j][4 + i] = w1[i]; } } }
        const bf16* pk = proj + (size_t)(b * SEQ) * 4096 + colk; const bf16* pv = proj + (size_t)(b * SEQ) * 4096 + colv;
        u32x4 rkA[4], rkB[4], rvA[2], rvB[2];
#define PA_LOAD_RAW(rk, rv, c_) do { if (tid < 256) { _Pragma("unroll") for (int j_ = 0; j_ < 4; ++j_) { const int tt_ = 64 * (c_) + sk - 3 + j_; \
            rk[j_] = (tt_ >= 0) ? *(const u32x4*)(pk + (size_t)tt_ * 4096) : (u32x4){0u, 0u, 0u, 0u}; } } \
            _Pragma("unroll") for (int i_ = 0; i_ < 2; ++i_) rv[i_] = *(const u32x4*)(pv + (size_t)(64 * (c_) + s0 + 32 * i_) * 4096); } while (0)
#pragma unroll
        for (int j = 0; j < 4; ++j) { rkA[j] = (u32x4){0u, 0u, 0u, 0u}; rkB[j] = (u32x4){0u, 0u, 0u, 0u}; }
        PA_LOAD_RAW(rkA, rvA, 0);
        float lfn = LF[(size_t)bh * SEQ + lane], ign = IG[(size_t)bh * SEQ + lane];
        f32x16 acc = {}; float mprev = 0.f;
        const bf16x8 ones = (bf16x8){0x3F80, 0x3F80, 0x3F80, 0x3F80, 0x3F80, 0x3F80, 0x3F80, 0x3F80};
#define PA_CHUNK(c, rkc, rvc, rkn, rvn) do { \
            const int buf = c & 1; \
            if (c + 1 < 32) PA_LOAD_RAW(rkn, rvn, c + 1); \
            const float lf = lfn, ig = ign; \
            if (c + 1 < 32) { lfn = LF[(size_t)bh * SEQ + 64 * (c + 1) + lane]; ign = IG[(size_t)bh * SEQ + 64 * (c + 1) + lane]; } \
            const float bcum = wave_scan_add(lf, lane), bL = lane63(bcum); \
            const float g = bL - bcum + ig, gmax = wave_max(g, lane), mnew = fmaxf(bL + mprev, gmax); \
            const float w = exp_f(g - mnew), decay = exp_f(bL + mprev - mnew); \
            if (wave < 4) { bf16* cp = CST + (((size_t)(bh * 32 + c) * 128 + 32 * wave + r32) * 128) + 32 * ds + 4 * hh; \
                _Pragma("unroll") for (int q = 0; q < 4; ++q) { u32x2 pk_; pk_.x = pk2(acc[4 * q], acc[4 * q + 1]); pk_.y = pk2(acc[4 * q + 2], acc[4 * q + 3]); *(u32x2*)(cp + 8 * q) = pk_; } } \
            else if (wave == 4 && r32 == 0) { float* np = NS + (size_t)(bh * 32 + c) * 128 + 32 * ds + 4 * hh; \
                _Pragma("unroll") for (int q = 0; q < 4; ++q) *(f32x4*)(np + 8 * q) = (f32x4){acc[4 * q], acc[4 * q + 1], acc[4 * q + 2], acc[4 * q + 3]}; } \
            if (tid == 0 && ds == 0) MS[bh * 32 + c] = mprev; \
            if (tid < 256) { float a[8]; \
                _Pragma("unroll") for (int ch = 0; ch < 8; ++ch) a[ch] = bs8[ch]; \
                _Pragma("unroll") for (int j = 0; j < 4; ++j) { const u32x4 x = rkc[j]; \
                    a[0] += wt[j][0] * bflo(x.x); a[1] += wt[j][1] * bfhi(x.x); a[2] += wt[j][2] * bflo(x.y); a[3] += wt[j][3] * bfhi(x.y); \
                    a[4] += wt[j][4] * bflo(x.z); a[5] += wt[j][5] * bfhi(x.z); a[6] += wt[j][6] * bflo(x.w); a[7] += wt[j][7] * bfhi(x.w); } \
                const float ws = __shfl(w, sk) * 0.08838834764831845f; \
                _Pragma("unroll") for (int ch = 0; ch < 8; ++ch) a[ch] = a[ch] * __builtin_amdgcn_rcpf(1.0f + __builtin_amdgcn_exp2f(-LOG2E * a[ch])) * ws; \
                u32x4 o; o.x = pk2(a[0], a[1]); o.y = pk2(a[2], a[3]); o.z = pk2(a[4], a[5]); o.w = pk2(a[6], a[7]); \
                *(LAS u32x4*)(F.lds + PA_KS + buf * PA_KSB + (sk * 40 + dg * 8) * 2) = o; } \
            _Pragma("unroll") for (int i = 0; i < 2; ++i) *(LAS u32x4*)(F.lds + PA_VS + buf * PA_VSB + ((s0 + 32 * i) * 136 + eg * 8) * 2) = rvc[i]; \
            LDS_BARRIER(); \
            _Pragma("unroll") for (int r = 0; r < 16; ++r) acc[r] *= decay; \
            if (wave < 4) { \
                _Pragma("unroll") for (int ks = 0; ks < 4; ++ks) { const bf16x8 a = tr_frag(F.lds + PA_KS + buf * PA_KSB + (16 * ks * 40) * 2, 80, lane); \
                    const bf16x8 bb = tr_frag(F.lds + PA_VS + buf * PA_VSB + (16 * ks * 136 + 32 * wave) * 2, 272, lane); acc = MFMA32(a, bb, acc); } \
            } else if (wave == 4) { \
                _Pragma("unroll") for (int ks = 0; ks < 4; ++ks) { const bf16x8 a = tr_frag(F.lds + PA_KS + buf * PA_KSB + (16 * ks * 40) * 2, 80, lane); acc = MFMA32(a, ones, acc); } \
            } \
            mprev = mnew; \
        } while (0)
        for (int c2 = 0; c2 < 32; c2 += 2) { PA_CHUNK(c2, rkA, rvA, rkB, rvB); PA_CHUNK((c2 + 1), rkB, rvB, rkA, rvA); }
#undef PA_CHUNK
#undef PA_LOAD_RAW
        LDS_BARRIER();
    }
}
constexpr int PB_QS = 0, PB_KS = 17408, PB_VT = 34816, PB_SQK = 53248, PB_HF = 62464, PB_NV = 96256, PB_MR = 96768, PB_AR = 97024, PB_EM = 97280, PB_CW = 97536, PB_CB = PB_CW + 4096, PB_NG = PB_CB + 1024;
__device__ __forceinline__ void conv8_regs(const u32x4& r0, const u32x4& r1, const u32x4& r2, const u32x4& r3, const LAS float* CW, const LAS float* CB, int m, int dg, float scale, u32x4& o) {
    const u32x4 r[4] = {r0, r1, r2, r3};
    const f32x4 b0 = *(const LAS f32x4*)(CB + m * 128 + dg * 8), b1 = *(const LAS f32x4*)(CB + m * 128 + dg * 8 + 4);
    float a[8] = {b0[0], b0[1], b0[2], b0[3], b1[0], b1[1], b1[2], b1[3]};
#pragma unroll
    for (int j = 0; j < 4; ++j) { const f32x4 w0 = *(const LAS f32x4*)(CW + (m * 4 + j) * 128 + dg * 8), w1 = *(const LAS f32x4*)(CW + (m * 4 + j) * 128 + dg * 8 + 4); const u32x4 x = r[j];
        a[0] += w0[0] * bflo(x.x); a[1] += w0[1] * bfhi(x.x); a[2] += w0[2] * bflo(x.y); a[3] += w0[3] * bfhi(x.y);
        a[4] += w1[0] * bflo(x.z); a[5] += w1[1] * bfhi(x.z); a[6] += w1[2] * bflo(x.w); a[7] += w1[3] * bfhi(x.w); }
#pragma unroll
    for (int i = 0; i < 8; ++i) a[i] = a[i] * __builtin_amdgcn_rcpf(1.0f + __builtin_amdgcn_exp2f(-LOG2E * a[i])) * scale;
    o.x = pk2(a[0], a[1]); o.y = pk2(a[2], a[3]); o.z = pk2(a[4], a[5]); o.w = pk2(a[6], a[7]);
}
__device__ __forceinline__ void mlstm_pass_b(Frame& F, const bf16* proj, const float* IG, const float* LF, const float* cw, const float* cb, const bf16* CST, const float* NS, const float* MS, const float* ng, bf16* Y) {
    const int tid = F.tid, lane = F.lane, wave = F.wave, r32 = lane & 31, hh = lane >> 5;
    LAS float* MR = (LAS float*)(F.lds + PB_MR); LAS float* AR = (LAS float*)(F.lds + PB_AR); LAS float* EM = (LAS float*)(F.lds + PB_EM); LAS float* NV = (LAS float*)(F.lds + PB_NV);
    LAS float* CW = (LAS float*)(F.lds + PB_CW); LAS float* CB = (LAS float*)(F.lds + PB_CB);
    const int dg = tid & 15, s0 = tid >> 4;
    for (int base = F.vcu * 8; base < 2048; base += F.G * 8) {
        const int bh = base >> 5, b = bh >> 3, h = bh & 7, c0 = base & 31;
        for (int e2 = tid; e2 < 1024; e2 += NWAVES * 64) { const int m = e2 >> 9, j = (e2 >> 7) & 3, ch = e2 & 127; CW[e2] = cw[j * 2048 + m * 1024 + h * 128 + ch]; }
        if (tid < 256) CB[tid] = cb[(tid >> 7) * 1024 + h * 128 + (tid & 127)];
        if (tid >= 256 && tid < 384) ((LAS float*)(F.lds + PB_NG))[tid - 256] = ng[h * 128 + tid - 256];
        LDS_BARRIER();
        const bf16* pq = proj + (size_t)(b * SEQ) * 4096 + h * 128 + dg * 8;
        const int hcol = h * 128 + 16 * (tid & 7);
        u32x4 rq[5], rk[5], rv[2]; float lfn, ign, msn, nvn = 0.f;
#define PB_LOAD_RAW(c_) do { _Pragma("unroll") for (int j_ = 0; j_ < 5; ++j_) { const int tt_ = 64 * (c_) + 2 * s0 - 3 + j_; \
              rq[j_] = (tt_ >= 0) ? *(const u32x4*)(pq + (size_t)tt_ * 4096) : (u32x4){0u, 0u, 0u, 0u}; rk[j_] = (tt_ >= 0) ? *(const u32x4*)(pq + (size_t)tt_ * 4096 + 1024) : (u32x4){0u, 0u, 0u, 0u}; } \
            _Pragma("unroll") for (int i_ = 0; i_ < 2; ++i_) rv[i_] = *(const u32x4*)(pq + (size_t)(64 * (c_) + 2 * s0 + i_) * 4096 + 2048); \
            lfn = LF[(size_t)bh * SEQ + 64 * (c_) + lane]; ign = IG[(size_t)bh * SEQ + 64 * (c_) + lane]; msn = MS[bh * 32 + (c_)]; if (tid < 128) nvn = NS[(size_t)(bh * 32 + (c_)) * 128 + tid]; } while (0)
        PB_LOAD_RAW(c0);
        for (int i8 = 0; i8 < 8; ++i8) {
        const int c = c0 + i8;
        const float lf = lfn, ig = ign, mprev = msn;
        const int ti = wave >> 2, ej = wave & 3;
        bf16x8 cfr[8];
        { const bf16* cp = CST + ((size_t)(bh * 32 + c) * 128 + 32 * ej + r32) * 128 + 8 * hh;
#pragma unroll
          for (int ks = 0; ks < 8; ++ks) cfr[ks] = *(const bf16x8*)(cp + 16 * ks); }
        const float bcum = wave_scan_add(lf, lane), uu = ig - bcum, pm = wave_scan_max(uu, lane), Mt = fmaxf(mprev, pm);
        if (wave == 0) { MR[lane] = Mt; AR[lane] = exp_f(mprev - Mt); EM[lane] = exp_f(-(bcum + Mt)); }
#pragma unroll
        for (int i = 0; i < 2; ++i) { const int s = 2 * s0 + i; u32x4 o;
            conv8_regs(rq[i], rq[i + 1], rq[i + 2], rq[i + 3], CW, CB, 0, dg, 1.0f, o); *(LAS u32x4*)(F.lds + PB_QS + (s * 136 + dg * 8) * 2) = o;
            conv8_regs(rk[i], rk[i + 1], rk[i + 2], rk[i + 3], CW, CB, 1, dg, 0.08838834764831845f, o); *(LAS u32x4*)(F.lds + PB_KS + (s * 136 + dg * 8) * 2) = o;
            *(LAS u32x4*)(F.lds + PB_VT + (s * 136 + dg * 8) * 2) = rv[i]; }
        const size_t hrow = (size_t)(b * SEQ + 64 * c + (tid >> 3));
        const u32x4 og0 = __builtin_nontemporal_load((const u32x4*)(proj + hrow * 4096 + 3072 + hcol)), og1 = __builtin_nontemporal_load((const u32x4*)(proj + hrow * 4096 + 3072 + hcol + 8));
        if (tid < 128) NV[tid] = nvn;
        if (i8 + 1 < 8) PB_LOAD_RAW(c + 1);
        LDS_BARRIER();
        f32x16 acc = {};
        {
#pragma unroll
          for (int ks = 0; ks < 8; ++ks) { const bf16x8 a = *(const LAS bf16x8*)(F.lds + PB_QS + ((32 * ti + r32) * 136 + 16 * ks + 8 * hh) * 2); acc = MFMA32(a, cfr[ks], acc); }
#pragma unroll
          for (int q = 0; q < 4; ++q) { const f32x4 av = *(const LAS f32x4*)(AR + 32 * ti + 8 * q + 4 * hh);
#pragma unroll
              for (int j = 0; j < 4; ++j) acc[4 * q + j] *= av[j]; } }
        if (wave < 3) { const int sti = (wave + 1) >> 1, sj = wave >> 1;
            f32x16 sa = {};
#pragma unroll
            for (int ks = 0; ks < 8; ++ks) { const bf16x8 a = *(const LAS bf16x8*)(F.lds + PB_QS + ((32 * sti + r32) * 136 + 16 * ks + 8 * hh) * 2); const bf16x8 bb = *(const LAS bf16x8*)(F.lds + PB_KS + ((32 * sj + r32) * 136 + 16 * ks + 8 * hh) * 2); sa = MFMA32(a, bb, sa); }
            const int s = 32 * sj + r32; const float us = __shfl(uu, s);
#pragma unroll
            for (int q = 0; q < 4; ++q) { const f32x4 mv = *(const LAS f32x4*)(MR + 32 * sti + 8 * q + 4 * hh);
#pragma unroll
                for (int j = 0; j < 4; ++j) { const int t = 32 * sti + 8 * q + 4 * hh + j; const float val = (s <= t) ? sa[4 * q + j] * exp_f(us - mv[j]) : 0.f;
                    *((LAS bf16*)(F.lds + PB_SQK) + t * 72 + s) = (bf16)(pk2(val, 0.f) & 0xffffu); } }
        } else if (wave == 3) {
#pragma unroll
            for (int r = 0; r < 16; ++r) { const int t = (r & 3) + 8 * (r >> 2) + 4 * hh; *((LAS bf16*)(F.lds + PB_SQK) + t * 72 + 32 + r32) = (bf16)0; } }
        LDS_BARRIER();
#pragma unroll
        for (int ks = 0; ks < 4; ++ks) { const bf16x8 a = *(const LAS bf16x8*)(F.lds + PB_SQK + ((32 * ti + r32) * 72 + 16 * ks + 8 * hh) * 2); const bf16x8 bb = tr_frag(F.lds + PB_VT + (16 * ks * 136 + 32 * ej) * 2, 272, lane); acc = MFMA32(a, bb, acc); }
#pragma unroll
        for (int r = 0; r < 16; ++r) { const int t = 32 * ti + (r & 3) + 8 * (r >> 2) + 4 * hh; *((LAS float*)(F.lds + PB_HF) + t * 132 + 32 * ej + r32) = acc[r]; }
        LDS_BARRIER();
        { const int t = tid >> 3, p = tid & 7; float dq = 0.f, ds = 0.f;
          { const u32x4 q0 = *(const LAS u32x4*)(F.lds + PB_QS + (t * 136 + 16 * p) * 2), q1 = *(const LAS u32x4*)(F.lds + PB_QS + (t * 136 + 16 * p + 8) * 2);
            const LAS f32x4* nv = (const LAS f32x4*)(NV + 16 * p); const f32x4 n0 = nv[0], n1 = nv[1], n2 = nv[2], n3 = nv[3];
            dq = (bflo(q0.x) * n0[0] + bfhi(q0.x) * n0[1]) + (bflo(q0.y) * n0[2] + bfhi(q0.y) * n0[3]) + (bflo(q0.z) * n1[0] + bfhi(q0.z) * n1[1]) + (bflo(q0.w) * n1[2] + bfhi(q0.w) * n1[3])
               + (bflo(q1.x) * n2[0] + bfhi(q1.x) * n2[1]) + (bflo(q1.y) * n2[2] + bfhi(q1.y) * n2[3]) + (bflo(q1.z) * n3[0] + bfhi(q1.z) * n3[1]) + (bflo(q1.w) * n3[2] + bfhi(q1.w) * n3[3]);
            const u32x4 sq = *(const LAS u32x4*)(F.lds + PB_SQK + (t * 72 + 8 * p) * 2);
            ds = ((bflo(sq.x) + bfhi(sq.x)) + (bflo(sq.y) + bfhi(sq.y))) + ((bflo(sq.z) + bfhi(sq.z)) + (bflo(sq.w) + bfhi(sq.w))); }
          float den = AR[t] * dq + ds; den += __shfl_xor(den, 1); den += __shfl_xor(den, 2); den += __shfl_xor(den, 4);
          const float inv = __builtin_amdgcn_rcpf(fmaxf(fabsf(den), EM[t]));
          const LAS f32x4* hp = (const LAS f32x4*)((LAS float*)(F.lds + PB_HF) + t * 132 + 16 * p); float x[16]; float ss = 0.f;
#pragma unroll
          for (int i = 0; i < 4; ++i) { const f32x4 v = hp[i]; x[4 * i] = v[0] * inv; x[4 * i + 1] = v[1] * inv; x[4 * i + 2] = v[2] * inv; x[4 * i + 3] = v[3] * inv; }
#pragma unroll
          for (int i = 0; i < 16; ++i) ss += x[i] * x[i];
          ss += __shfl_xor(ss, 1); ss += __shfl_xor(ss, 2); ss += __shfl_xor(ss, 4);
          const float rn = __builtin_amdgcn_rsqf(ss * (1.0f / 128.0f) + EPS);
          const size_t row = hrow; const int col = hcol;
          const unsigned ow[8] = {og0.x, og0.y, og0.z, og0.w, og1.x, og1.y, og1.z, og1.w};
          const LAS f32x4* gq = (const LAS f32x4*)((LAS float*)(F.lds + PB_NG) + 16 * p); const f32x4 ng0 = gq[0], ng1 = gq[1], ng2 = gq[2], ng3 = gq[3];
          const float gn[16] = {ng0[0], ng0[1], ng0[2], ng0[3], ng1[0], ng1[1], ng1[2], ng1[3], ng2[0], ng2[1], ng2[2], ng2[3], ng3[0], ng3[1], ng3[2], ng3[3]};
          unsigned res[8];
#pragma unroll
          for (int i = 0; i < 8; ++i) res[i] = pk2(x[2 * i] * rn * gn[2 * i] * sigmoid_f(bflo(ow[i])), x[2 * i + 1] * rn * gn[2 * i + 1] * sigmoid_f(bfhi(ow[i])));
          pg8::st16(Y + row * 1024 + col, (u32x4){res[0], res[1], res[2], res[3]}); pg8::st16(Y + row * 1024 + col + 8, (u32x4){res[4], res[5], res[6], res[7]}); }
        LDS_BARRIER();
        }
#undef PB_LOAD_RAW
    }
}

constexpr int SG_VT = 0, SG_WS = 256 * 136 * 2, SG_ST = SG_WS + 128 * 136 * 2;
__device__ __forceinline__ void sgu_phase(Frame& F, const bf16* Z, const float* lnp, const float* lg, const float* lb, const bf16* WM, const float* bs, bf16* OUT) {
    const int tid = F.tid, lane = F.lane, wave = F.wave, r32 = lane & 31, hh = lane >> 5;
    LAS float* ST = (LAS float*)(F.lds + SG_ST);
    for (int u = F.vcu; u < 1024; u += F.G) {
        const int span = u >> 3, g = u & 7; const size_t row0 = (size_t)span * 128;
        { const int r = tid >> 2, p = tid & 3; const f32x4* pp = (const f32x4*)(lnp + ((row0 + r) * 32 + 8 * p) * 2); float s1 = 0.f, s2 = 0.f;
#pragma unroll
          for (int i = 0; i < 4; ++i) { const f32x4 v = pp[i]; s1 += v[0] + v[2]; s2 += v[1] + v[3]; }
          s1 += __shfl_xor(s1, 1); s1 += __shfl_xor(s1, 2); s2 += __shfl_xor(s2, 1); s2 += __shfl_xor(s2, 2);
          const float mu = s1 * (1.0f / 2048.0f), var = fmaxf(s2 * (1.0f / 2048.0f) - mu * mu, 0.f);
          if (p == 0) { ST[2 * r] = mu; ST[2 * r + 1] = 1.0f / sqrtf(var + EPS); } }
#pragma unroll
        for (int i = 0; i < 4; ++i) { const int item = tid + 512 * i, t = item >> 4, sg = item & 15; *(LAS u32x4*)(F.lds + SG_WS + (t * 136 + sg * 8) * 2) = *(const u32x4*)(WM + ((size_t)g * 128 + t) * 128 + sg * 8); }
        __syncthreads();
#pragma unroll
        for (int i = 0; i < 8; ++i) { const int item = tid + 512 * i, s = item >> 5, cg8 = item & 31; const int col = g * 256 + cg8 * 8;
            const u32x4 x = *(const u32x4*)(Z + (row0 + s) * 4096 + 2048 + col); const float mu = ST[2 * s], rs = ST[2 * s + 1];
            const f32x4 g0 = *(const f32x4*)(lg + col), g1 = *(const f32x4*)(lg + col + 4), b0 = *(const f32x4*)(lb + col), b1 = *(const f32x4*)(lb + col + 4);
            LAS bf16* vt = (LAS bf16*)(F.lds + SG_VT) + (cg8 * 8) * 136 + s;
            vt[0 * 136] = (bf16)(pk2((bflo(x.x) - mu) * rs * g0[0] + b0[0], 0.f) & 0xffffu); vt[1 * 136] = (bf16)(pk2((bfhi(x.x) - mu) * rs * g0[1] + b0[1], 0.f) & 0xffffu);
            vt[2 * 136] = (bf16)(pk2((bflo(x.y) - mu) * rs * g0[2] + b0[2], 0.f) & 0xffffu); vt[3 * 136] = (bf16)(pk2((bfhi(x.y) - mu) * rs * g0[3] + b0[3], 0.f) & 0xffffu);
            vt[4 * 136] = (bf16)(pk2((bflo(x.z) - mu) * rs * g1[0] + b1[0], 0.f) & 0xffffu); vt[5 * 136] = (bf16)(pk2((bfhi(x.z) - mu) * rs * g1[1] + b1[1], 0.f) & 0xffffu);
            vt[6 * 136] = (bf16)(pk2((bflo(x.w) - mu) * rs * g1[2] + b1[2], 0.f) & 0xffffu); vt[7 * 136] = (bf16)(pk2((bfhi(x.w) - mu) * rs * g1[3] + b1[3], 0.f) & 0xffffu); }
        __syncthreads();
        f32x16 acc[4] = {};
#pragma unroll
        for (int ks = 0; ks < 8; ++ks) { const bf16x8 bb = *(const LAS bf16x8*)(F.lds + SG_VT + ((32 * wave + r32) * 136 + 16 * ks + 8 * hh) * 2);
#pragma unroll
            for (int ti = 0; ti < 4; ++ti) { const bf16x8 a = *(const LAS bf16x8*)(F.lds + SG_WS + ((32 * ti + r32) * 136 + 16 * ks + 8 * hh) * 2); acc[ti] = MFMA32(a, bb, acc[ti]); } }
        const int col = g * 256 + 32 * wave + r32;
#pragma unroll
        for (int ti = 0; ti < 4; ++ti)
#pragma unroll
            for (int r = 0; r < 16; ++r) { const int t = 32 * ti + (r & 3) + 8 * (r >> 2) + 4 * hh; const float uv = bf2f(Z[(row0 + t) * 4096 + col]);
                OUT[(row0 + t) * 2048 + col] = (bf16)(pk2(uv * (acc[ti][r] + bs[g * 128 + t]), 0.f) & 0xffffu); }
        __syncthreads();
    }
}

constexpr int SG2_VI = 0, SG2_WS = 67584, SG2_ST = SG2_WS + 34816, SG2_BS = SG2_ST + 1024;
__device__ __forceinline__ void sgu_phase2(Frame& F, const bf16* Z, const float* lnp, const float* lg, const float* lb, const bf16* WM, const float* bs, bf16* OUT) {
    const int tid = F.tid, lane = F.lane, wave = F.wave, r32 = lane & 31, hh = lane >> 5;
    LAS float* ST = (LAS float*)(F.lds + SG2_ST); LAS float* BS = (LAS float*)(F.lds + SG2_BS); LAS float* SF = (LAS float*)(F.lds + SG2_VI);
    for (int u = F.vcu; u < 1024; u += F.G) {
        const int span = u >> 3, g = u & 7; const size_t row0 = (size_t)span * 128;
        const int cg8 = tid & 31, colv = g * 256 + cg8 * 8;
        u32x4 xv[8];
#pragma unroll
        for (int i = 0; i < 8; ++i) xv[i] = __builtin_nontemporal_load((const u32x4*)(Z + (row0 + (tid >> 5) + 16 * i) * 4096 + 2048 + colv));
        u32x4 wmv[4];
#pragma unroll
        for (int i = 0; i < 4; ++i) { const int item = tid + 512 * i, t = item >> 4, sg = item & 15; wmv[i] = *(const u32x4*)(WM + ((size_t)g * 128 + t) * 128 + sg * 8); }
        const f32x4 g0 = *(const f32x4*)(lg + colv), g1 = *(const f32x4*)(lg + colv + 4), b0 = *(const f32x4*)(lb + colv), b1 = *(const f32x4*)(lb + colv + 4);
        { const int r = tid >> 2, p = tid & 3; const f32x4* pp = (const f32x4*)(lnp + ((row0 + r) * 32 + 8 * p) * 2); float s1 = 0.f, s2 = 0.f;
#pragma unroll
          for (int i = 0; i < 4; ++i) { const f32x4 v = pp[i]; s1 += v[0] + v[2]; s2 += v[1] + v[3]; }
          s1 += __shfl_xor(s1, 1); s1 += __shfl_xor(s1, 2); s2 += __shfl_xor(s2, 1); s2 += __shfl_xor(s2, 2);
          const float mu = s1 * (1.0f / 2048.0f), var = fmaxf(s2 * (1.0f / 2048.0f) - mu * mu, 0.f);
          if (p == 0) { ST[2 * r] = mu; ST[2 * r + 1] = 1.0f / sqrtf(var + EPS); } }
        if (tid < 128) BS[tid] = bs[g * 128 + tid];
#pragma unroll
        for (int i = 0; i < 4; ++i) { const int item = tid + 512 * i, t = item >> 4, sg = item & 15; *(LAS u32x4*)(F.lds + SG2_WS + (t * 136 + sg * 8) * 2) = wmv[i]; }
        LDS_BARRIER();
#pragma unroll
        for (int i = 0; i < 8; ++i) { const int s = (tid >> 5) + 16 * i; const u32x4 x = xv[i]; const float mu = ST[2 * s], rs = ST[2 * s + 1];
            u32x4 o; o.x = pk2((bflo(x.x) - mu) * rs * g0[0] + b0[0], (bfhi(x.x) - mu) * rs * g0[1] + b0[1]); o.y = pk2((bflo(x.y) - mu) * rs * g0[2] + b0[2], (bfhi(x.y) - mu) * rs * g0[3] + b0[3]);
            o.z = pk2((bflo(x.z) - mu) * rs * g1[0] + b1[0], (bfhi(x.z) - mu) * rs * g1[1] + b1[1]); o.w = pk2((bflo(x.w) - mu) * rs * g1[2] + b1[2], (bfhi(x.w) - mu) * rs * g1[3] + b1[3]);
            *(LAS u32x4*)(F.lds + SG2_VI + (s * 264 + cg8 * 8) * 2) = o; }
        u32x4 uv[2][4];
#pragma unroll
        for (int p = 0; p < 2; ++p)
#pragma unroll
            for (int i = 0; i < 4; ++i) { const int idx = tid + 512 * i, tl = idx >> 5, c8 = idx & 31; uv[p][i] = __builtin_nontemporal_load((const u32x4*)(Z + (row0 + 64 * p + tl) * 4096 + g * 256 + c8 * 8)); }
        LDS_BARRIER();
        f32x16 acc[4] = {};
#pragma unroll
        for (int ks = 0; ks < 8; ++ks) { const bf16x8 bb = tr_frag(F.lds + SG2_VI + (16 * ks * 264 + 32 * wave) * 2, 528, lane);
#pragma unroll
            for (int ti = 0; ti < 4; ++ti) { const bf16x8 a = *(const LAS bf16x8*)(F.lds + SG2_WS + ((32 * ti + r32) * 136 + 16 * ks + 8 * hh) * 2); acc[ti] = MFMA32(a, bb, acc[ti]); } }
        LDS_BARRIER();
#pragma unroll
        for (int p = 0; p < 2; ++p) {
#pragma unroll
            for (int tt = 0; tt < 2; ++tt)
#pragma unroll
                for (int r = 0; r < 16; ++r) { const int tl = 32 * tt + (r & 3) + 8 * (r >> 2) + 4 * hh; SF[tl * 260 + 32 * wave + r32] = acc[2 * p + tt][r] + BS[64 * p + tl]; }
            LDS_BARRIER();
#pragma unroll
            for (int i = 0; i < 4; ++i) { const int idx = tid + 512 * i, tl = idx >> 5, c8 = idx & 31; const size_t row = row0 + 64 * p + tl; const int col = g * 256 + c8 * 8;
                const f32x4 f0 = *(const LAS f32x4*)(SF + tl * 260 + c8 * 8), f1 = *(const LAS f32x4*)(SF + tl * 260 + c8 * 8 + 4);
                const u32x4 x = uv[p][i];
                u32x4 o; o.x = pk2(bflo(x.x) * f0[0], bfhi(x.x) * f0[1]); o.y = pk2(bflo(x.y) * f0[2], bfhi(x.y) * f0[3]); o.z = pk2(bflo(x.z) * f1[0], bfhi(x.z) * f1[1]); o.w = pk2(bflo(x.w) * f1[2], bfhi(x.w) * f1[3]);
                pg8::st16(OUT + row * 2048 + col, o); }
            LDS_BARRIER();
        }
    }
}
__device__ __forceinline__ void final_norm(Frame& F, const float* ssq, const float* fg) {
    const int gw = F.vcu * NWAVES + F.wave, NGW = F.G * NWAVES, lane = F.lane; const bf16* XB = (const bf16*)(F.ws + WS_XB);
    for (int m = gw; m < M; m += NGW) {
        float s = (lane < 16) ? ssq[(size_t)m * 16 + lane] : 0.f; s = wave_sum(s);
        const float r = 1.0f / sqrtf(s * (1.0f / 1024.0f) + EPS);
        const unsigned long long* xi = (const unsigned long long*)(XB + (size_t)m * D) + lane; f32x4* xo = (f32x4*)(F.out + (size_t)m * D) + lane; const f32x4* gp = (const f32x4*)fg + lane;
#pragma unroll
        for (int j = 0; j < 4; ++j) { const unsigned long long w = __builtin_nontemporal_load(xi + 64 * j); const unsigned w0 = (unsigned)w, w1 = (unsigned)(w >> 32); const f32x4 gg = gp[64 * j];
            __builtin_nontemporal_store((f32x4){bflo(w0) * r * gg[0], bfhi(w0) * r * gg[1], bflo(w1) * r * gg[2], bfhi(w1) * r * gg[3]}, xo + 64 * j); }
    }
}

struct Args { const float* in[22]; float* out; unsigned char* ws; int ph_lo, ph_hi; };
constexpr int NPHASE = 26;
__global__ void __launch_bounds__(NWAVES * 64, 2) mk_fwd(Args args) {
    extern __shared__ __attribute__((aligned(16))) unsigned char lds_raw[];
    __builtin_assume(threadIdx.y == 0); __builtin_assume(threadIdx.z == 0);
    const int wv0 = __builtin_amdgcn_readfirstlane((int)threadIdx.x >> 6);
    Frame F;
    F.lds = (ldsp)lds_raw;
    F.inp = args.in;
    F.out = args.out; F.ws = args.ws;
    cg::grid_group grid = cg::this_grid();
    { const int t0 = mk_ltid(wv0); for (int u = t0; u < 128; u += NWAVES * 64) ((LAS unsigned*)(F.lds + LDSCTL_OFF))[u] = 0u; __syncthreads();
    }
    XcdBarrier bar = xcd_barrier_post((unsigned*)args.ws + CW_BAR, (volatile LAS unsigned*)(F.lds + LDSCTL_OFF) + 8, mk_ltid(wv0));
#ifndef MK_REP_N
#define MK_REP_N 0
#endif
#ifndef MK_REP_MATCH
#define MK_REP_MATCH(ph, slot, kind) false
#endif
#ifndef MK_EXTRA_SYNCS
#define MK_EXTRA_SYNCS 0
#endif
    int rep = 0;
    for (int ph = args.ph_lo; ph < args.ph_hi; ) {
        bool did = true;
        F.tid = mk_ltid(wv0); F.lane = F.tid & 63; F.wave = __builtin_amdgcn_readfirstlane(F.tid >> 6);
        int bx = blockIdx.x, gd = gridDim.x; asm volatile("" : "+s"(bx), "+s"(gd)); F.G = gd; F.vcu = (gd % 8 == 0) ? (bx % 8) * (gd / 8) + bx / 8 : bx;
        unsigned long long wsi = (unsigned long long)args.ws; asm volatile("" : "+s"(wsi)); unsigned char* ws = (unsigned char*)(__attribute__((address_space(1))) unsigned char*)wsi; F.ws = ws;
        float* SSQ = (float*)(ws + WS_SSQ); bf16* XB = (bf16*)(ws + WS_XB); bf16* PROJ = (bf16*)(ws + WS_PROJ);
        if (ph == 0) {
#ifndef DIS_P0
 p0_prologue(F);
#endif
 }
        else if (ph == NPHASE - 1) {
#ifndef DIS_FIN
 final_norm(F, SSQ, F.in_(3));
#endif
 }
        else {
            const int layer = (ph - 1) / 6, slot = (ph - 1) % 6, kind = layer % 3, j = layer / 3;
            if (slot == 0) {
                if (kind == 2) {
                    pg8::Gemm g{XB, (const bf16*)(ws + WS_W + W_CIN), M, 4096, D}; pg8::StaticOrder S; S.init(M, 4096, F.G, bx);
                    RstdPre pre{&S, SSQ, (LAS float*)(F.lds + RS_OFF)}; pg8::EpiGeluLn E{PROJ, (const LAS float*)(F.lds + RS_OFF), (float*)(ws + WS_LNP)};
#ifndef DIS_G3
                    pg8::gemm_phase<pg8::EpiGeluLn, pg8::StaticOrder, PG8_ALIGN, PG8_SP2, RstdPre>(F.lds, g, S, E, wv0, pre);
#endif
                } else {
                    const int N = (kind == 0) ? 3072 : 4096;
                    pg8::Gemm g{XB, (const bf16*)(ws + WS_W + ((kind == 0) ? W_AIN + j * SZ_AIN : W_BIN)), M, N, D}; pg8::StaticOrder S; S.init(M, N, F.G, bx);
                    RstdPre pre{&S, SSQ, (LAS float*)(F.lds + RS_OFF)}; pg8::EpiScaleBf16 E{PROJ, (kind == 0) ? 1024 : 4096, (const LAS float*)(F.lds + RS_OFF), (kind == 0) ? 1024 : 0, (size_t)16 * MiB, attn_body::C2};
#ifndef DIS_G1
                    pg8::gemm_phase<pg8::EpiScaleBf16, pg8::StaticOrder, PG8_ALIGN, PG8_SP2, RstdPre>(F.lds, g, S, E, wv0, pre);
#endif
#ifndef DIS_GATE
                    if (kind == 0) gate_items<0>(F, XB, (const bf16*)(ws + WS_WG) + (size_t)j * 16384, SSQ, F.in_(5) + j * 16, nullptr, (float*)(ws + WS_LOGF), nullptr);
                    else gate_items<1>(F, XB, (const bf16*)(ws + WS_WG) + (size_t)2 * 16384, SSQ, F.in_(10), F.in_(11), (float*)(ws + WS_IG), (float*)(ws + WS_LF));
#endif
                }
            } else if (slot == 1) {
                if (kind == 0) {
                    const attn_body::AttnTensors AT{(const attn_body::bf16*)PROJ, (const attn_body::bf16*)(ws + WS_PROJ + 32 * MiB), (const attn_body::bf16*)(ws + WS_PROJ + 64 * MiB), (attn_body::bf16*)PROJ, (const float*)(ws + WS_LOGF)};
                    const attn_body::StaticOrder S((int)F.G, bx);
#ifdef MK_ATTN_TWICE
                    { const attn_body::AttnTensors AT0{AT.Q, AT.K, AT.V, (attn_body::bf16*)(ws + WS_S1), AT.LOGF}; attn_body::attn_phase<attn_body::StaticOrder>((char*)lds_raw, AT0, S, wv0); xcd_barrier(bar, F.tid); }
#endif
#ifndef DIS_ATTN
                    attn_body::attn_phase<attn_body::StaticOrder>((char*)lds_raw, AT, S, wv0);
#endif
                } else if (kind == 1) {
#ifndef DIS_PA
                    mlstm_pass_a(F, PROJ, (const float*)(ws + WS_IG), (const float*)(ws + WS_LF), F.in_(8), F.in_(9), (bf16*)F.out, (float*)(ws + WS_NS), (float*)(ws + WS_MS));
#endif
                } else {
#ifndef DIS_SGU
                    sgu_phase2(F, PROJ, (const float*)(ws + WS_LNP), F.in_(15), F.in_(16), (const bf16*)(ws + WS_WM), F.in_(18), (bf16*)(ws + WS_S1));
#endif
                }
            } else if (slot == 2) {
#ifndef DIS_PB
                if (kind == 1) mlstm_pass_b(F, PROJ, (const float*)(ws + WS_IG), (const float*)(ws + WS_LF), F.in_(8), F.in_(9), (const bf16*)F.out, (const float*)(ws + WS_NS), (const float*)(ws + WS_MS), F.in_(12), (bf16*)(ws + WS_S2));
                else
#endif
                did = false;
            } else if (slot == 3 || slot == 5) {
                const bf16* A; const bf16* Bt; int K;
                if (slot == 5) { A = PROJ; Bt = (const bf16*)(ws + WS_W + W_DN + layer * SZ_DN); K = DFF; }
                else if (kind == 0) { A = PROJ; Bt = (const bf16*)(ws + WS_W + W_AOUT + j * SZ_AOUT); K = D; }
                else if (kind == 1) { A = (const bf16*)(ws + WS_S2); Bt = (const bf16*)(ws + WS_W + W_BOUT); K = D; }
                else { A = (const bf16*)(ws + WS_S1); Bt = (const bf16*)(ws + WS_W + W_COUT); K = 2048; }
                pg8::Gemm g{A, Bt, M, D, K}; pg8::StaticOrder S; S.init(M, D, F.G, bx);
#ifdef MK_RES_TWICE
                if (MK_RES_TWICE(slot, kind)) { bf16* scr = (slot == 5) ? (bf16*)(ws + WS_S1) : (kind == 0) ? (bf16*)(ws + WS_PROJ + 64 * MiB) : PROJ;
                    pg8::EpiResidualB E0{XB, scr, (float*)(ws + WS_LNP)}; pg8::gemm_phase<pg8::EpiResidualB, pg8::StaticOrder, false, PG8_SP2>(F.lds, g, S, E0, wv0); xcd_barrier(bar, F.tid); }
#endif
                pg8::EpiResidualB E{XB, XB, SSQ};
#ifndef DIS_G4
                pg8::gemm_phase<pg8::EpiResidualB, pg8::StaticOrder, false, PG8_SP2>(F.lds, g, S, E, wv0);
#endif
            } else {
                pg8::Gemm g{XB, (const bf16*)(ws + WS_W + W_GU + layer * SZ_GU), M, 2 * DFF, D}; pg8::StaticOrder S; S.init(M, 2 * DFF, F.G, bx);
                RstdPre pre{&S, SSQ, (LAS float*)(F.lds + RS_OFF)}; pg8::EpiSwiGLU E{PROJ, (const LAS float*)(F.lds + RS_OFF)};
#ifndef DIS_G2
                pg8::gemm_phase<pg8::EpiSwiGLU, pg8::StaticOrder, PG8_ALIGN, PG8_SP2, RstdPre>(F.lds, g, S, E, wv0, pre);
                if (F.G == 256 && layer < 3 && bx >= 128) p0_convert(F, layer + 1, false, (bx - 128) * NWAVES + F.wave, 128 * NWAVES, P0_FFN);
#endif
            }
        }
        if (did && ph + 1 < args.ph_hi) { const int ns = (MK_EXTRA_SYNCS > 0 && ph == 1) ? 1 + MK_EXTRA_SYNCS : 1;
            if (args.ph_hi < 0) grid.sync();
            for (int k = 0; k < ns; ++k) xcd_barrier(bar, F.tid); }
        if (MK_REP_N > 0 && ph > 0 && ph < NPHASE - 1 && MK_REP_MATCH(ph, ((ph - 1) % 6), (((ph - 1) / 6) % 3)) && rep < MK_REP_N) ++rep; else if (MK_REP_N > 0 && ph == 0 && MK_REP_MATCH(0, -1, -1) && rep < MK_REP_N) ++rep; else { rep = 0; ++ph; }
    }
}

#ifndef MK_PER_PHASE
#define MK_PER_PHASE 0
#endif
extern "C" void kernel_launch(void* const* d_in, const int* in_sizes, int n_in, void* d_out, int out_size, void* d_ws, size_t ws_size, hipStream_t stream) {
    static int grid = 0;
    if (grid == 0) {
        if (n_in != 22 || out_size != M * D || ws_size < WS_END) { fprintf(stderr, "kernel_launch: unexpected shapes (n_in %d out %d ws %zu)\n", n_in, out_size, ws_size); grid = -1; return; }
        int dev = 0, cus = 0, per_cu = 0;
        (void)hipGetDevice(&dev); (void)hipDeviceGetAttribute(&cus, hipDeviceAttributeMultiprocessorCount, dev);
        if (hipFuncSetAttribute((const void*)mk_fwd, hipFuncAttributeMaxDynamicSharedMemorySize, LDS_BYTES) != hipSuccess) { fprintf(stderr, "kernel_launch: hipFuncSetAttribute failed\n"); grid = -1; return; }
        if (hipOccupancyMaxActiveBlocksPerMultiprocessor(&per_cu, (const void*)mk_fwd, NWAVES * 64, LDS_BYTES) != hipSuccess || per_cu < 1) { fprintf(stderr, "kernel_launch: occupancy query says %d\n", per_cu); per_cu = 1; }
        (void)hipGetLastError();
        grid = cus;
        fprintf(stderr, "kernel_launch: grid %d (per_cu %d)\n", grid, per_cu);
    }
    if (grid < 0) return;
    if (hipMemsetAsync(d_ws, 0, CTL_ZERO_BYTES, stream) != hipSuccess) { fprintf(stderr, "kernel_launch: memset failed\n"); return; }
    Args a{};
    for (int i = 0; i < 22; ++i) a.in[i] = (const float*)d_in[i];
    a.out = (float*)d_out; a.ws = (unsigned char*)d_ws;
#if MK_PER_PHASE
    for (int ph = 0; ph < NPHASE; ++ph) { a.ph_lo = ph; a.ph_hi = ph + 1; void* kargs[] = {&a};
        hipError_t e = hipLaunchCooperativeKernel((const void*)mk_fwd, dim3(grid), dim3(NWAVES * 64), kargs, LDS_BYTES, stream);
        if (e != hipSuccess) { fprintf(stderr, "launch failed: %s\n", hipGetErrorString(e)); break; } }
#else
    a.ph_lo = 0; a.ph_hi = NPHASE; void* kargs[] = {&a};
    hipError_t e = hipLaunchCooperativeKernel((const void*)mk_fwd, dim3(grid), dim3(NWAVES * 64), kargs, LDS_BYTES, stream);
    if (e != hipSuccess) fprintf(stderr, "cooperative launch failed: %s (grid %d)\n", hipGetErrorString(e), grid);
#endif
}
```

```cpp
#include <hip/hip_cooperative_groups.h>
#include <hip/hip_runtime.h>
__device__ __forceinline__ int mk_ltid(int wv) { unsigned z = 0u; asm volatile("" : "+s"(z)); int t = (wv << 6) | (int)__builtin_amdgcn_mbcnt_hi(~0u, __builtin_amdgcn_mbcnt_lo(~0u, z)); asm volatile("" : "+v"(t)); return t; }
#include <hip/hip_runtime.h>
#include <cstdio>
#include <cstdint>
namespace pg8 {
#define PG8_LAS __attribute__((address_space(3)))
typedef unsigned short bf16_t;
typedef short bf16x8 __attribute__((ext_vector_type(8)));
typedef float f32x4 __attribute__((ext_vector_type(4)));
typedef unsigned u32x4 __attribute__((ext_vector_type(4)));
constexpr int BM = 256, BK = 64, HALF = 128, HTB = HALF * BK * 2  , STAGE_BYTES = 8 * HTB, NXCD = 8, WGM = 2;

__host__ __device__ __forceinline__ int lds_byte(int r, int c) { const int st = (r >> 4) * 2 + (c >> 5), rr = r & 15, cc = c & 31, ob = rr * 64 + cc * 2; return st * 1024 + (ob ^ (((ob >> 9) & 1) << 5)); }
__host__ __device__ __forceinline__ void stage_rc(int b, int& R, int& C) { const int st = b / 1024, sb = b % 1024, swz = sb ^ (((sb >> 9) & 1) << 5); R = (st >> 1) * 16 + swz / 64; C = (st & 1) * 32 + (swz % 64) / 2; }
__host__ __device__ __forceinline__ int perm32(int rho) { const int n = rho >> 4, i = rho & 15; return 8 * (i >> 2) + 4 * n + (i & 3); }

struct Unit { int pm, pn, ord; };
struct Gemm { const bf16_t* A; const bf16_t* Bt; int M, N, K; };

struct StaticOrder {
    int nM, nN, nwg, G, c;
    __host__ __device__ void init(int M, int N, int G_, int c_) { nM = M / BM; nN = N / BM; nwg = nM * nN; G = G_; c = c_; }
    __host__ __device__ bool next(int i, Unit& u) const {
        const long L = (long)i * G + c; if (L >= nwg) return false;
        int wgid = (int)L; { const int q = nwg / NXCD, r = nwg % NXCD, xcd = wgid % NXCD, off = wgid / NXCD; wgid = (xcd < r ? xcd * (q + 1) : r * (q + 1) + (xcd - r) * q) + off; }
#if defined(PG8_NMAJOR) && PG8_NMAJOR
        u.pm = wgid % nM; u.pn = wgid / nM; u.ord = i; return true;
#else
        const int nig = WGM * nN, gid = wgid / nig, fm = gid * WGM, gsz = (nM - fm) < WGM ? (nM - fm) : WGM;
        u.pm = fm + ((wgid % nig) % gsz); u.pn = (wgid % nig) / gsz; u.ord = i; return true;
#endif
    }
    __device__ __forceinline__ void a_ready(const Unit&) const {}
    __device__ __forceinline__ void done(const Unit&) const {}
};

__device__ __forceinline__ unsigned cvt_pk_bf16(float lo, float hi) { unsigned r; asm volatile("v_cvt_pk_bf16_f32 %0, %1, %2" : "=v"(r) : "v"(lo), "v"(hi)); return r; }
typedef float f32x2 __attribute__((ext_vector_type(2)));
__device__ __forceinline__ f32x2 gelu_pk(f32x2 v) {
    const f32x2 av = __builtin_elementwise_abs(v), d = av * 0.2316418882f + 1.0f;
    f32x2 t; t.x = __builtin_amdgcn_rcpf(d.x); t.y = __builtin_amdgcn_rcpf(d.y);
    f32x2 q = t * 0.5307027145f + (-0.7265760135f); q = q * t + 0.7107068705f; q = q * t + (-0.142248368f); q = q * t + 0.127414796f; q = q * t;
    const f32x2 s = (v * v) * (-0.72134752044f);
    f32x2 e; e.x = __builtin_amdgcn_exp2f(s.x); e.y = __builtin_amdgcn_exp2f(s.y);
    const f32x2 m = v * (q * e), r = v - m;
    f32x2 o; o.x = v.x < 0.f ? m.x : r.x; o.y = v.y < 0.f ? m.y : r.y; return o;
}

__device__ __forceinline__ float row_rstd(const float* ssq, int row, int fq) {
    const f32x4 v = *(const f32x4*)(ssq + (size_t)row * 16 + 4 * fq);
    float s = (v[0] + v[1]) + (v[2] + v[3]); s += __shfl_xor(s, 16); s += __shfl_xor(s, 32);
    return 1.0f / sqrtf(s * (1.0f / 1024.0f) + 1e-6f);
}
__device__ __forceinline__ unsigned pkbf(float lo, float hi) { typedef float f2_t __attribute__((ext_vector_type(2))); typedef __bf16 b2_t __attribute__((ext_vector_type(2))); f2_t v = {lo, hi}; b2_t b = __builtin_convertvector(v, b2_t); return __builtin_bit_cast(unsigned, b); }

#ifndef PG8_ST_MODE
#define PG8_ST_MODE 1
#endif
__device__ __forceinline__ void st16(void* p, u32x4 v) {
    asm volatile("global_store_dwordx4 %0, %1, off sc1\n\ts_nop 1" :: "v"(p), "v"(v) : "memory");
}
__device__ __forceinline__ void st16o(const void* base, unsigned off, u32x4 v) { asm volatile("global_store_dwordx4 %0, %1, %2 sc1\n\ts_nop 1" :: "v"(off), "v"(v), "s"(base) : "memory"); }
__device__ __forceinline__ u32x4 ld16o(const void* base, unsigned off) { return *(const u32x4*)((const char*)base + off); }
__device__ __forceinline__ void st16e(void* p, u32x4 v) {
#if PG8_ST_MODE == 0
    *(u32x4*)p = v;
#elif PG8_ST_MODE == 1
    asm volatile("global_store_dwordx4 %0, %1, off sc1\n\ts_nop 1" :: "v"(p), "v"(v) : "memory");
#elif PG8_ST_MODE == 2
    asm volatile("global_store_dwordx4 %0, %1, off sc1 nt\n\ts_nop 1" :: "v"(p), "v"(v) : "memory");
#else
    asm volatile("global_store_dwordx4 %0, %1, off nt\n\ts_nop 1" :: "v"(p), "v"(v) : "memory");
#endif
}
struct EpiScaleBf16 {
    static constexpr bool PERM = true, AFTER_DRAIN = false;
    bf16_t* O; int ldc; const PG8_LAS float* rs; int split_cols; size_t split_stride; float scale0;
    __device__ __forceinline__ void operator()(const f32x4 (&acc)[2][2][4][2], const Unit& u, int wr, int wc, int fr, int fq) const {
        const int row0 = u.pm * BM + wr * 64 + fr; int colt = u.pn * BM; bf16_t* base = O;
        float sc = 1.f; if (split_cols) { const int t = colt / split_cols; base += (size_t)t * split_stride; colt -= t * split_cols; if (t == 0) sc = scale0; }
        const int col0 = colt + wc * 32 + 8 * fq;
#pragma unroll
        for (int ai = 0; ai < 2; ++ai)
#pragma unroll
            for (int m = 0; m < 4; ++m) { const int row = row0 + ai * HALF + m * 16; const float r = rs[u.ord * 256 + wr * 64 + fr + ai * HALF + m * 16] * sc; bf16_t* rowp = base + (size_t)row * ldc + col0;
#pragma unroll
                for (int bj = 0; bj < 2; ++bj) { const f32x4 v0 = acc[ai][bj][m][0] * r, v1 = acc[ai][bj][m][1] * r;
                    u32x4 w; w.x = pkbf(v0[0], v0[1]); w.y = pkbf(v0[2], v0[3]); w.z = pkbf(v1[0], v1[1]); w.w = pkbf(v1[2], v1[3]);
                    st16e(rowp + bj * HALF, w); } }
    }
};
__device__ __forceinline__ float silu_f(float x) { return x * __builtin_amdgcn_rcpf(1.0f + __builtin_amdgcn_exp2f(-1.4426950408889634f * x)); }
struct EpiSwiGLU {
    static constexpr bool PERM = true, AFTER_DRAIN = false;
    bf16_t* O; const PG8_LAS float* rs;
    __device__ __forceinline__ void operator()(const f32x4 (&acc)[2][2][4][2], const Unit& u, int wr, int wc, int fr, int fq) const {
        const int row0 = u.pm * BM + wr * 64 + fr, col0 = u.pn * HALF + wc * 32 + 8 * fq;
#pragma unroll
        for (int ai = 0; ai < 2; ++ai)
#pragma unroll
            for (int m = 0; m < 4; ++m) { const int row = row0 + ai * HALF + m * 16; const float r = rs[u.ord * 256 + wr * 64 + fr + ai * HALF + m * 16];
                const f32x4 G0 = acc[ai][0][m][0], G1 = acc[ai][0][m][1], U0 = acc[ai][1][m][0], U1 = acc[ai][1][m][1];
                const float c = -1.4426950408889634f * r, r2 = r * r;
                f32x4 a0, a1;
#pragma unroll
                for (int h = 0; h < 2; ++h) {
                    const f32x2 ga = {G0[2 * h], G0[2 * h + 1]}, gb = {G1[2 * h], G1[2 * h + 1]}, ua = {U0[2 * h], U0[2 * h + 1]}, ub = {U1[2 * h], U1[2 * h + 1]};
                    const f32x2 ta = ga * c, tb = gb * c; f32x2 ea, eb;
                    ea.x = __builtin_amdgcn_exp2f(ta.x); ea.y = __builtin_amdgcn_exp2f(ta.y); eb.x = __builtin_amdgcn_exp2f(tb.x); eb.y = __builtin_amdgcn_exp2f(tb.y);
                    const f32x2 da = ea + 1.0f, db = eb + 1.0f; f32x2 sa, sb;
                    sa.x = __builtin_amdgcn_rcpf(da.x); sa.y = __builtin_amdgcn_rcpf(da.y); sb.x = __builtin_amdgcn_rcpf(db.x); sb.y = __builtin_amdgcn_rcpf(db.y);
                    const f32x2 oa = ((ga * ua) * r2) * sa, ob = ((gb * ub) * r2) * sb;
                    a0[2 * h] = oa.x; a0[2 * h + 1] = oa.y; a1[2 * h] = ob.x; a1[2 * h + 1] = ob.y; }
                u32x4 w; w.x = pkbf(a0[0], a0[1]); w.y = pkbf(a0[2], a0[3]); w.z = pkbf(a1[0], a1[1]); w.w = pkbf(a1[2], a1[3]);
                st16e(O + (size_t)row * 2816 + col0, w); }
    }
};
struct EpiGeluLn {
    static constexpr bool PERM = true, AFTER_DRAIN = false;
    bf16_t* O; const PG8_LAS float* rs; float* lnp;
    __device__ __forceinline__ void operator()(const f32x4 (&acc)[2][2][4][2], const Unit& u, int wr, int wc, int fr, int fq) const {
        const int row0 = u.pm * BM + wr * 64 + fr, col0 = u.pn * BM + wc * 32 + 8 * fq;
#pragma unroll
        for (int ai = 0; ai < 2; ++ai)
#pragma unroll
            for (int m = 0; m < 4; ++m) { const int row = row0 + ai * HALF + m * 16; const float r = rs[u.ord * 256 + wr * 64 + fr + ai * HALF + m * 16]; bf16_t* rowp = O + (size_t)row * 4096 + col0;
                float s1 = 0.f, s2 = 0.f;
#pragma unroll
                for (int bj = 0; bj < 2; ++bj) { const f32x4 v0 = acc[ai][bj][m][0] * r, v1 = acc[ai][bj][m][1] * r;
                    const f32x2 a = gelu_pk((f32x2){v0[0], v0[1]}), b = gelu_pk((f32x2){v0[2], v0[3]}), c = gelu_pk((f32x2){v1[0], v1[1]}), d = gelu_pk((f32x2){v1[2], v1[3]});
                    s1 += ((a.x + a.y) + (b.x + b.y)) + ((c.x + c.y) + (d.x + d.y));
                    s2 += ((a.x * a.x + a.y * a.y) + (b.x * b.x + b.y * b.y)) + ((c.x * c.x + c.y * c.y) + (d.x * d.x + d.y * d.y));
                    u32x4 w; w.x = pkbf(a.x, a.y); w.y = pkbf(b.x, b.y); w.z = pkbf(c.x, c.y); w.w = pkbf(d.x, d.y);
                    st16e(rowp + bj * HALF, w); }
                if (u.pn >= 8) { s1 += __shfl_xor(s1, 16); s1 += __shfl_xor(s1, 32); s2 += __shfl_xor(s2, 16); s2 += __shfl_xor(s2, 32);
                    if (fq == 0) *(f32x2*)(lnp + ((size_t)row * 32 + (u.pn - 8) * 4 + wc) * 2) = (f32x2){s1, s2}; } }
    }
};
struct EpiResidual {
    static constexpr bool PERM = true, AFTER_DRAIN = false;
    const float* X; float* Xo; bf16_t* XB; float* ssq;
    __device__ __forceinline__ void operator()(const f32x4 (&acc)[2][2][4][2], const Unit& u, int wr, int wc, int fr, int fq) const {
        const int row0 = u.pm * BM + wr * 64 + fr, col0 = u.pn * BM + wc * 32 + 8 * fq;
#pragma unroll
        for (int ai = 0; ai < 2; ++ai)
#pragma unroll
            for (int m = 0; m < 4; ++m) { const int row = row0 + ai * HALF + m * 16; const float* xp = X + (size_t)row * 1024 + col0; float* xq = Xo + (size_t)row * 1024 + col0; bf16_t* bp = XB + (size_t)row * 1024 + col0; float q = 0.f;
#pragma unroll
                for (int bj = 0; bj < 2; ++bj) { f32x4 x0 = *(const f32x4*)(xp + bj * HALF), x1 = *(const f32x4*)(xp + bj * HALF + 4);
                    x0 += acc[ai][bj][m][0]; x1 += acc[ai][bj][m][1];
                    *(f32x4*)(xq + bj * HALF) = x0; *(f32x4*)(xq + bj * HALF + 4) = x1;
                    q += ((x0[0] * x0[0] + x0[1] * x0[1]) + (x0[2] * x0[2] + x0[3] * x0[3])) + ((x1[0] * x1[0] + x1[1] * x1[1]) + (x1[2] * x1[2] + x1[3] * x1[3]));
                    u32x4 w; w.x = pkbf(x0[0], x0[1]); w.y = pkbf(x0[2], x0[3]); w.z = pkbf(x1[0], x1[1]); w.w = pkbf(x1[2], x1[3]);
                    *(u32x4*)(bp + bj * HALF) = w; }
                q += __shfl_xor(q, 16); q += __shfl_xor(q, 32);
                if (fq == 0) ssq[(size_t)row * 16 + u.pn * 4 + wc] = q; }
    }
};

struct EpiResidualLds {
    static constexpr bool PERM = true, AFTER_DRAIN = true;
    const float* X; float* Xo; bf16_t* XB; float* ssq;
    __device__ __forceinline__ void operator()(const f32x4 (&)[2][2][4][2], const Unit&, int, int, int, int) const {}
    __device__ __forceinline__ void fused(f32x4 (&acc)[2][2][4][2], const Unit& u, int wr, int wc, int fr, int fq, PG8_LAS unsigned char* lds, int wid, int lane) const {
#pragma unroll
        for (int ai = 0; ai < 2; ++ai) {
#pragma unroll
            for (int m = 0; m < 4; ++m) { const int rl = 64 * wr + 16 * m + fr;
#pragma unroll
                for (int bj = 0; bj < 2; ++bj)
#pragma unroll
                    for (int n = 0; n < 2; ++n) { const int ch = 32 * bj + 8 * wc + 2 * fq + n; *(PG8_LAS f32x4*)(lds + rl * 1024 + ((ch ^ (rl & 7)) << 4)) = acc[ai][bj][m][n]; } }
            asm volatile("s_waitcnt lgkmcnt(0)" ::: "memory"); __builtin_amdgcn_s_barrier(); asm volatile("" ::: "memory");
#pragma unroll 4
            for (int i = 0; i < 16; ++i) { const int rl = 16 * wid + i; const size_t off = (size_t)(u.pm * BM + 128 * ai + rl) * 1024 + u.pn * BM + 4 * lane;
                const f32x4 a = *(const PG8_LAS f32x4*)(lds + rl * 1024 + ((lane ^ (rl & 7)) << 4));
                f32x4 x = *(const f32x4*)(X + off); x += a; *(f32x4*)(Xo + off) = x;
                float q = (x[0] * x[0] + x[1] * x[1]) + (x[2] * x[2] + x[3] * x[3]);
                typedef unsigned u32x2_t __attribute__((ext_vector_type(2))); u32x2_t w; w.x = pkbf(x[0], x[1]); w.y = pkbf(x[2], x[3]); *(u32x2_t*)(XB + off) = w;
#pragma unroll
                for (int o = 1; o < 64; o <<= 1) q += __shfl_xor(q, o);
                if (lane == 0) *(f32x4*)(ssq + (size_t)(u.pm * BM + 128 * ai + rl) * 16 + u.pn * 4) = (f32x4){q, 0.f, 0.f, 0.f}; }
            asm volatile("s_waitcnt lgkmcnt(0)" ::: "memory"); __builtin_amdgcn_s_barrier(); asm volatile("" ::: "memory");
        }
    }
};

struct EpiResidualB {
    static constexpr bool PERM = true, AFTER_DRAIN = false;
    bf16_t* XB; bf16_t* XBo; float* ssq;
    int fin; float* out; const float* fg; unsigned* cnt; unsigned* tmo;
    __device__ __forceinline__ void operator()(const f32x4 (&acc)[2][2][4][2], const Unit& u, int wr, int wc, int fr, int fq) const {
        const int row0 = u.pm * BM + wr * 64 + fr, col0 = u.pn * BM + wc * 32 + 8 * fq;
        const unsigned off0 = (unsigned)(row0 * 1024 + col0) * 2u;
        f32x4 s[2][4][2][2]; u32x4 xv[2][4][2];
#pragma unroll
        for (int ai = 0; ai < 2; ++ai)
#pragma unroll
            for (int m = 0; m < 4; ++m)
#pragma unroll
                for (int bj = 0; bj < 2; ++bj) xv[ai][m][bj] = ld16o(XB, off0 + (unsigned)((ai * HALF + m * 16) * 2048 + bj * HALF * 2));
#pragma unroll
        for (int ai = 0; ai < 2; ++ai) {
#pragma unroll
            for (int m = 0; m < 4; ++m)
#pragma unroll
                for (int bj = 0; bj < 2; ++bj) { const u32x4 x = xv[ai][m][bj]; const f32x4 a0 = acc[ai][bj][m][0], a1 = acc[ai][bj][m][1];
                    s[ai][m][bj][0] = (f32x4){__uint_as_float(x.x << 16) + a0[0], __uint_as_float(x.x & 0xffff0000u) + a0[1], __uint_as_float(x.y << 16) + a0[2], __uint_as_float(x.y & 0xffff0000u) + a0[3]};
                    s[ai][m][bj][1] = (f32x4){__uint_as_float(x.z << 16) + a1[0], __uint_as_float(x.z & 0xffff0000u) + a1[1], __uint_as_float(x.w << 16) + a1[2], __uint_as_float(x.w & 0xffff0000u) + a1[3]}; }
#pragma unroll
            for (int m = 0; m < 4; ++m)
#pragma unroll
                for (int bj = 0; bj < 2; ++bj) asm volatile("" : "+v"(s[ai][m][bj][0]), "+v"(s[ai][m][bj][1]));
            asm volatile("" ::: "memory"); }
        if (fin) {
#pragma unroll
            for (int ai = 0; ai < 2; ++ai)
#pragma unroll
                for (int m = 0; m < 4; ++m) { float q = 0.f;
#pragma unroll
                    for (int bj = 0; bj < 2; ++bj) { const f32x4 t0 = s[ai][m][bj][0], t1 = s[ai][m][bj][1];
                        q += ((t0[0] * t0[0] + t0[1] * t0[1]) + (t0[2] * t0[2] + t0[3] * t0[3])) + ((t1[0] * t1[0] + t1[1] * t1[1]) + (t1[2] * t1[2] + t1[3] * t1[3])); }
                    q += __shfl_xor(q, 16); q += __shfl_xor(q, 32);
                    if (fq == 0) ssq[(size_t)(row0 + ai * HALF + m * 16) * 16 + u.pn * 4 + wc] = q; }
            asm volatile("s_waitcnt vmcnt(0)" ::: "memory");
            __syncthreads();
            if (wr == 0 && wc == 1 && fr == 0 && fq == 0) asm volatile("buffer_inv sc1" ::: "memory");
            if (wr == 0 && wc == 0 && fr == 0 && fq == 0) {
                unsigned* c = cnt + u.pm * 16;
                __builtin_amdgcn_fence(__ATOMIC_RELEASE, "agent"); asm volatile("s_waitcnt vmcnt(0)" ::: "memory");
                (void)__hip_atomic_fetch_add(c, 1u, __ATOMIC_RELAXED, __HIP_MEMORY_SCOPE_AGENT);
                unsigned sp = 0u;
                while (__hip_atomic_load(c, __ATOMIC_RELAXED, __HIP_MEMORY_SCOPE_AGENT) < 4u) { __builtin_amdgcn_s_sleep(1);
                    if ((++sp & 255u) == 0u) { if (__hip_atomic_load(tmo, __ATOMIC_RELAXED, __HIP_MEMORY_SCOPE_AGENT)) break; if (sp > (1u << 18)) { atomicAdd(tmo, 1u); break; } } }
            }
            if (wr == 0 && wc == 1 && fr == 0 && fq == 0) asm volatile("s_waitcnt vmcnt(0)" ::: "memory");
            __syncthreads();
            f32x4 gg[2][2];
#pragma unroll
            for (int bj = 0; bj < 2; ++bj) { gg[bj][0] = *(const f32x4*)(fg + col0 + bj * HALF); gg[bj][1] = *(const f32x4*)(fg + col0 + bj * HALF + 4); }
#pragma unroll
            for (int ai = 0; ai < 2; ++ai)
#pragma unroll
                for (int m = 0; m < 4; ++m) { const int row = row0 + ai * HALF + m * 16; const float r = row_rstd(ssq, row, fq); float* op = out + (size_t)row * 1024 + col0;
#pragma unroll
                    for (int bj = 0; bj < 2; ++bj) { __builtin_nontemporal_store(s[ai][m][bj][0] * gg[bj][0] * r, (f32x4*)(op + bj * HALF)); __builtin_nontemporal_store(s[ai][m][bj][1] * gg[bj][1] * r, (f32x4*)(op + bj * HALF + 4)); } }
            return;
        }
#pragma unroll
        for (int ai = 0; ai < 2; ++ai)
#pragma unroll
            for (int m = 0; m < 4; ++m) { const int row = row0 + ai * HALF + m * 16; float q = 0.f;
#pragma unroll
                for (int bj = 0; bj < 2; ++bj) { const f32x4 a0 = s[ai][m][bj][0], a1 = s[ai][m][bj][1];
                    u32x4 w; w.x = pkbf(a0[0], a0[1]); w.y = pkbf(a0[2], a0[3]); w.z = pkbf(a1[0], a1[1]); w.w = pkbf(a1[2], a1[3]);
                    st16o(XBo, off0 + (unsigned)((ai * HALF + m * 16) * 2048 + bj * HALF * 2), w);
#pragma unroll
                    for (int k = 0; k < 4; ++k) { const float lo = __uint_as_float(w[k] << 16), hi = __uint_as_float(w[k] & 0xffff0000u); q += lo * lo + hi * hi; } }
                q += __shfl_xor(q, 16); q += __shfl_xor(q, 32);
                if (fq == 0) ssq[(size_t)row * 16 + u.pn * 4 + wc] = q; }
    }
};
struct NoPre { __device__ __forceinline__ void issue(int) {} __device__ __forceinline__ void finish(int) {} };
template <class Epi, class Sched, bool ALIGN_EPI = false, bool SP2 = false, class Pre = NoPre>
__device__ __forceinline__ void gemm_phase(PG8_LAS unsigned char* lds, const Gemm g, const Sched& S, const Epi& E, const int wv, Pre pre = Pre(), const bool bpre = false) {
    const int tid = mk_ltid(wv), wid = __builtin_amdgcn_readfirstlane(tid >> 6), lane = tid & 63, wr = wid >> 2, wc = wid & 3, fr = lane & 15, fq = lane >> 4;
    const int K = g.K, nt = K / BK;
    unsigned voffA[2], voffB[2];
#pragma unroll
    for (int i = 0; i < 2; ++i) { int R, C; stage_rc(tid * 16 + i * 8192, R, C); const int Rb = Epi::PERM ? ((R & ~31) + perm32(R & 31)) : R;
        voffA[i] = (unsigned)(R * K + C) * 2u; voffB[i] = (unsigned)(Rb * K + C) * 2u; }
    const size_t kstep = (size_t)(BK * 2);
    const size_t hstep = (size_t)HALF * K * 2;
    const size_t tstep = 2 * hstep;
    const unsigned ldsw = (unsigned)wid * 1024u;
    const int aoff = lds_byte(wr * 64 + fr, fq * 8), boff = lds_byte(wc * 32 + fr, fq * 8);
#define PG8_SA(b, h) (((b) * 2 + (h)) * HTB)
#define PG8_SB(b, h) ((4 + (b) * 2 + (h)) * HTB)
#ifndef PG8_AUX_A
#define PG8_AUX_A 1
#endif
#ifndef PG8_AUX_B
#define PG8_AUX_B 1
#endif
#define PG8_STAGE_X(bufoff, gbase, voff, AUX) do { _Pragma("unroll") for (int _i = 0; _i < 2; ++_i) \
        __builtin_amdgcn_global_load_lds((const unsigned*)((const char*)(gbase) + (voff)[_i]), (PG8_LAS unsigned*)(lds + (bufoff) + ldsw + _i * 8192), 16, 0, AUX); } while (0)
#define PG8_STAGE(bufoff, gbase, voff) PG8_STAGE_X(bufoff, gbase, voff, PG8_AUX_A)
#define PG8_STAGEB(bufoff, gbase, voff) PG8_STAGE_X(bufoff, gbase, voff, PG8_AUX_B)
#define PG8_LDA(dst, b, h) do { _Pragma("unroll") for (int m = 0; m < 4; ++m) _Pragma("unroll") for (int k = 0; k < 2; ++k) dst[m][k] = *(const PG8_LAS bf16x8*)(lds + PG8_SA(b, h) + aoff + m * 2048 + k * 1024); } while (0)
#define PG8_LDB(dst, b, h) do { _Pragma("unroll") for (int n = 0; n < 2; ++n) _Pragma("unroll") for (int k = 0; k < 2; ++k) dst[n][k] = *(const PG8_LAS bf16x8*)(lds + PG8_SB(b, h) + boff + n * 2048 + k * 1024); } while (0)
#define PG8_MMA(ai, bj, At, Bt) do { __builtin_amdgcn_s_setprio(1); _Pragma("unroll") for (int m = 0; m < 4; ++m) _Pragma("unroll") for (int n = 0; n < 2; ++n) _Pragma("unroll") for (int k = 0; k < 2; ++k) \
        acc[ai][bj][m][n] = __builtin_amdgcn_mfma_f32_16x16x32_bf16(Bt[n][k], At[m][k], acc[ai][bj][m][n], 0, 0, 0); __builtin_amdgcn_s_setprio(0); } while (0)
#define PG8_WAIT_V(n) asm volatile("s_waitcnt vmcnt(" #n ")" ::: "memory")
#define PG8_WAIT_L(n) asm volatile("s_waitcnt lgkmcnt(" #n ")" ::: "memory")
#define PG8_BAR __builtin_amdgcn_s_barrier()
#define PG8_SCHED __builtin_amdgcn_sched_barrier(0)
#ifndef PG8_DMA1ST
#define PG8_DMA1ST 0
#endif
#if PG8_DMA1ST
#define PG8_DMA_FIRST(stages, reads) do { stages; PG8_SCHED; reads; } while (0)
#else
#define PG8_DMA_FIRST(stages, reads) do { reads; stages; } while (0)
#endif
    Unit cur, nxt; int ui = 0;
    if (!S.next(0, cur)) return;
    f32x4 acc[2][2][4][2];
#pragma unroll
    for (int a = 0; a < 2; ++a)
#pragma unroll
        for (int b = 0; b < 2; ++b)
#pragma unroll
            for (int m = 0; m < 4; ++m)
#pragma unroll
                for (int n = 0; n < 2; ++n) acc[a][b][m][n] = (f32x4){0.f, 0.f, 0.f, 0.f};
    bf16x8 At[4][2], B0[2][2], B1[2][2];
    const char* cA = (const char*)g.A + (size_t)cur.pm * tstep; const char* cB = (const char*)g.Bt + (size_t)cur.pn * tstep;
    S.a_ready(cur);
    if constexpr (SP2) {
        pre.issue(tid);
        if (bpre) {
            PG8_STAGE(PG8_SA(0, 0), cA, voffA); PG8_STAGE(PG8_SA(0, 1), cA + hstep, voffA);
            pre.finish(tid);
            if (wr == 1) PG8_BAR;
            PG8_WAIT_V(2); PG8_BAR;
            PG8_STAGE(PG8_SA(1, 0), cA + kstep, voffA);
            PG8_WAIT_V(2); PG8_BAR;
        } else {
        PG8_STAGEB(PG8_SB(0, 0), cB, voffB); PG8_STAGEB(PG8_SB(0, 1), cB + hstep, voffB); PG8_STAGE(PG8_SA(0, 0), cA, voffA); PG8_STAGE(PG8_SA(0, 1), cA + hstep, voffA);
        pre.finish(tid);
        if (wr == 1) PG8_BAR;
        PG8_WAIT_V(2); PG8_BAR;
        PG8_STAGEB(PG8_SB(1, 0), cB + kstep, voffB); PG8_STAGE(PG8_SA(1, 0), cA + kstep, voffA); PG8_STAGEB(PG8_SB(1, 1), cB + hstep + kstep, voffB);
        PG8_WAIT_V(6); PG8_BAR;
        }
    } else {
        PG8_STAGEB(PG8_SB(0, 0), cB, voffB); PG8_STAGE(PG8_SA(0, 0), cA, voffA); PG8_STAGEB(PG8_SB(0, 1), cB + hstep, voffB); PG8_STAGE(PG8_SA(0, 1), cA + hstep, voffA);
        if (wr == 1) PG8_BAR;
        PG8_WAIT_V(4); PG8_BAR;
        PG8_STAGEB(PG8_SB(1, 0), cB + kstep, voffB); PG8_STAGE(PG8_SA(1, 0), cA + kstep, voffA); PG8_STAGEB(PG8_SB(1, 1), cB + hstep + kstep, voffB);
        PG8_WAIT_V(6); PG8_BAR;
    }
    for (;;) {
        const bool has_next = S.next(ui + 1, nxt);
        const char* nA = has_next ? (const char*)g.A + (size_t)nxt.pm * tstep : cA; const char* nB = has_next ? (const char*)g.Bt + (size_t)nxt.pn * tstep : cB;
        for (int t = 0; t < nt; t += 2) {
            const bool last = (t == nt - 2);
            const char* a1 = cA + (size_t)(t + 1) * kstep;
            const char* a2 = last ? nA : cA + (size_t)(t + 2) * kstep; const char* b2 = last ? nB : cB + (size_t)(t + 2) * kstep;
            const char* a3 = a2 + kstep; const char* b3 = b2 + kstep;
            if (last && has_next) S.a_ready(nxt);
            if constexpr (SP2) {
            PG8_DMA_FIRST(PG8_STAGE(PG8_SA(1, 1), a1 + hstep, voffA), PG8_LDB(B0, 0, 0); PG8_LDB(B1, 0, 1); PG8_SCHED; PG8_LDA(At, 0, 0));
            PG8_WAIT_V(8); PG8_WAIT_L(0); PG8_BAR; PG8_MMA(0, 0, At, B0); PG8_MMA(0, 1, At, B1); PG8_BAR; PG8_SCHED;
            PG8_DMA_FIRST(PG8_STAGEB(PG8_SB(0, 0), b2, voffB); PG8_STAGEB(PG8_SB(0, 1), b2 + hstep, voffB); PG8_STAGE(PG8_SA(0, 0), a2, voffA), PG8_LDA(At, 0, 1));
            PG8_WAIT_V(8); PG8_WAIT_L(0); PG8_BAR; PG8_MMA(1, 0, At, B0); PG8_MMA(1, 1, At, B1); PG8_BAR; PG8_SCHED;
            PG8_DMA_FIRST(PG8_STAGE(PG8_SA(0, 1), a2 + hstep, voffA), PG8_LDB(B0, 1, 0); PG8_LDB(B1, 1, 1); PG8_SCHED; PG8_LDA(At, 1, 0));
            PG8_WAIT_V(8); PG8_WAIT_L(0); PG8_BAR; PG8_MMA(0, 0, At, B0); PG8_MMA(0, 1, At, B1); PG8_BAR; PG8_SCHED;
            PG8_DMA_FIRST(PG8_STAGEB(PG8_SB(1, 0), b3, voffB); PG8_STAGEB(PG8_SB(1, 1), b3 + hstep, voffB); PG8_STAGE(PG8_SA(1, 0), a3, voffA), PG8_LDA(At, 1, 1));
            PG8_WAIT_V(8); PG8_WAIT_L(0); PG8_BAR; PG8_MMA(1, 0, At, B0); PG8_MMA(1, 1, At, B1); PG8_BAR; PG8_SCHED;
            } else {
            PG8_LDB(B0, 0, 0); PG8_SCHED; PG8_LDA(At, 0, 0); PG8_STAGE(PG8_SA(1, 1), a1 + hstep, voffA);
            PG8_WAIT_L(8); PG8_BAR; PG8_WAIT_L(0); PG8_MMA(0, 0, At, B0); PG8_BAR; PG8_SCHED;
            PG8_LDB(B1, 0, 1); PG8_STAGEB(PG8_SB(0, 0), b2, voffB);
            PG8_BAR; PG8_WAIT_L(0); PG8_MMA(0, 1, At, B1); PG8_BAR;
            PG8_LDA(At, 0, 1); PG8_STAGE(PG8_SA(0, 0), a2, voffA);
            PG8_BAR; PG8_WAIT_L(0); PG8_MMA(1, 0, At, B0); PG8_BAR; PG8_SCHED;
            PG8_STAGEB(PG8_SB(0, 1), b2 + hstep, voffB);
            PG8_WAIT_V(6); PG8_BAR; PG8_MMA(1, 1, At, B1); PG8_BAR;
            PG8_LDB(B0, 1, 0); PG8_SCHED; PG8_LDA(At, 1, 0); PG8_STAGE(PG8_SA(0, 1), a2 + hstep, voffA);
            PG8_WAIT_L(8); PG8_BAR; PG8_WAIT_L(0); PG8_MMA(0, 0, At, B0); PG8_BAR; PG8_SCHED;
            PG8_LDB(B1, 1, 1); PG8_STAGEB(PG8_SB(1, 0), b3, voffB);
            PG8_BAR; PG8_WAIT_L(0); PG8_MMA(0, 1, At, B1); PG8_BAR;
            PG8_LDA(At, 1, 1); PG8_STAGE(PG8_SA(1, 0), a3, voffA);
            PG8_BAR; PG8_WAIT_L(0); PG8_MMA(1, 0, At, B0); PG8_BAR; PG8_SCHED;
            PG8_STAGEB(PG8_SB(1, 1), b3 + hstep, voffB);
            PG8_WAIT_V(6); PG8_BAR; PG8_MMA(1, 1, At, B1); PG8_BAR;
            }
        }
        if constexpr (ALIGN_EPI) { if (wr == 0) PG8_BAR; }
        if constexpr (!Epi::AFTER_DRAIN) { E(acc, cur, wr, wc, fr, fq); S.done(cur); }
        if (!has_next) break;
#pragma unroll
        for (int a = 0; a < 2; ++a)
#pragma unroll
            for (int b = 0; b < 2; ++b)
#pragma unroll
                for (int m = 0; m < 4; ++m)
#pragma unroll
                    for (int n = 0; n < 2; ++n) acc[a][b][m][n] = (f32x4){0.f, 0.f, 0.f, 0.f};
        cur = nxt; cA = nA; cB = nB; ++ui;
        if constexpr (ALIGN_EPI) { if (wr == 1) PG8_BAR; }
    }
    PG8_WAIT_V(0);
    if constexpr (!ALIGN_EPI) { if (wr == 0) PG8_BAR; }
    PG8_BAR;
    if constexpr (Epi::AFTER_DRAIN) { E.fused(acc, cur, wr, wc, fr, fq, lds, wid, lane); S.done(cur); }
#undef PG8_SA
#undef PG8_SB
#undef PG8_STAGE
#undef PG8_STAGEB
#undef PG8_STAGE_X
#undef PG8_LDA
#undef PG8_LDB
#undef PG8_MMA
#undef PG8_WAIT_V
#undef PG8_WAIT_L
#undef PG8_BAR
#undef PG8_SCHED
#undef PG8_DMA_FIRST
}
template <bool PERM>
__device__ __forceinline__ void prestage_b(PG8_LAS unsigned char* lds, const bf16_t* Bt, int K, int pn, int wid, int lane) {
    const char* cB = (const char*)Bt + (size_t)pn * (size_t)BM * K * 2; const size_t kstep = (size_t)(BK * 2), hstep = (size_t)HALF * K * 2;
#pragma unroll
    for (int sl = 0; sl < 2; ++sl) { const int w = wid - 4 * sl, t = w * 64 + lane; const unsigned ldsw = (unsigned)w * 1024u;
#pragma unroll
        for (int i = 0; i < 2; ++i) { int R, C; stage_rc(t * 16 + i * 8192, R, C); const int Rb = PERM ? ((R & ~31) + perm32(R & 31)) : R; const unsigned vo = (unsigned)(Rb * K + C) * 2u;
#pragma unroll
            for (int q = 0; q < 4; ++q) { const int b = q >> 1, h = q & 1;
                __builtin_amdgcn_global_load_lds((const unsigned*)(cB + (size_t)b * kstep + (size_t)h * hstep + vo), (PG8_LAS unsigned*)(lds + (4 + b * 2 + h) * HTB + ldsw + i * 8192), 16, 0, PG8_AUX_B); } } }
}
}

#ifndef PG8_SP2
#define PG8_SP2 true
#endif
#ifndef PG8_ALIGN
#define PG8_ALIGN true
#endif
#include <hip/hip_bf16.h>
#include <cmath>
#ifndef ATTN_DMA_POL
#define ATTN_DMA_POL " sc0"
#endif
namespace attn_body {
using bf16=__hip_bfloat16;
using bf16x8=__attribute__((ext_vector_type(8)))short;
using s16x4=__attribute__((ext_vector_type(4)))short;
using f32x16=__attribute__((ext_vector_type(16)))float;
using u32x4=__attribute__((ext_vector_type(4)))unsigned;
constexpr int BATCH=8,NHEAD=16,SEQ=2048,D=64,DM=NHEAD*D;
constexpr int NW=8,QBLK=32,QB=QBLK*NW,KVBLK=64,NQB=SEQ/QB;
constexpr int ATTN_PITCH=DM, ATTN_UNIT_ROWS=QB;
__device__ __forceinline__ int crow(int r,int hi){return (r&3)+8*(r>>2)+4*hi;}
#define SBAR() __builtin_amdgcn_sched_barrier(0)
__device__ __forceinline__ void cmask(f32x16&p0,f32x16&p1,int jb,int qrel,int hi){
  const float NEG=-INFINITY; int kb=64*jb+4*hi;
  #pragma unroll
  for(int r=0;r<16;++r){int kv=kb+(r&3)+8*(r>>2); if(kv>qrel)p0[r]=NEG; if(kv+32>qrel)p1[r]=NEG;}
}

constexpr int NSLOT=3, SLOTB=8192;
constexpr int LDS_K=0, LDS_V=NSLOT*SLOTB, LDS_WS=2*NSLOT*SLOTB, LDS_OST=LDS_WS+NW*64*4, LDS_CB=LDS_OST+NW*4096, LDS_BYTES=LDS_CB+SEQ*4;
constexpr float C2=0.125f*1.4426950408889634f;
__device__ __forceinline__ void glds16(const void*gsrc,unsigned lds_dst){unsigned keep;
  asm volatile("s_mov_b32 %0, m0\n\ts_mov_b32 m0, %2\n\ts_nop 0\n\tglobal_load_lds_dwordx4 %1, off" ATTN_DMA_POL "\n\ts_mov_b32 m0, %0":"=&s"(keep):"v"(gsrc),"s"(lds_dst):"memory");}
__device__ __forceinline__ float max3f(float a,float b,float c){float r;asm("v_max3_f32 %0, %1, %2, %3":"=v"(r):"v"(a),"v"(b),"v"(c));return r;}
__device__ __forceinline__ float max2f(float a,float b){float r;asm("v_max_f32_e32 %0, %1, %2":"=v"(r):"v"(a),"v"(b));return r;}
__device__ __forceinline__ float fadd_s(float a,float b){float r;asm("v_add_f32_e32 %0, %1, %2":"=v"(r):"v"(a),"v"(b));return r;}
__device__ __forceinline__ float fsub_s(float a,float b){float r;asm("v_sub_f32_e32 %0, %1, %2":"=v"(r):"v"(a),"v"(b));return r;}
typedef float f32x2_t __attribute__((ext_vector_type(2))); typedef __bf16 bf16x2_t __attribute__((ext_vector_type(2)));
__device__ __forceinline__ unsigned cvtpk_s(float lo,float hi){f32x2_t v={lo,hi};bf16x2_t b=__builtin_convertvector(v,bf16x2_t);return __builtin_bit_cast(unsigned,b);}
#define WAIT_BAR(N) asm volatile("s_waitcnt vmcnt(" #N ") lgkmcnt(0)\n\ts_barrier":::"memory")

__device__ __forceinline__ void qkt(f32x16&p0,f32x16&p1,const char*Kslot,const bf16x8*qr,int r32,int hi){
  const char*kb=Kslot+hi*1024+r32*16;
  #pragma unroll
  for(int d0=0;d0<4;++d0){
    const bf16x8 b0=*reinterpret_cast<const bf16x8*>(kb+d0*2048);
    const bf16x8 b1=*reinterpret_cast<const bf16x8*>(kb+d0*2048+512);
    {p0=__builtin_amdgcn_mfma_f32_32x32x16_bf16(b0,qr[d0],p0,0,0,0);p1=__builtin_amdgcn_mfma_f32_32x32x16_bf16(b1,qr[d0],p1,0,0,0);}}
}
typedef __attribute__((address_space(3))) const char* lds_cptr;
typedef short v4i16_t __attribute__((ext_vector_type(4)));
__device__ __forceinline__ void kload8(bf16x8*kf,lds_cptr kp){
  kf[0]=*(const __attribute__((address_space(3))) bf16x8*)(kp);      kf[1]=*(const __attribute__((address_space(3))) bf16x8*)(kp+512);
  kf[2]=*(const __attribute__((address_space(3))) bf16x8*)(kp+2048); kf[3]=*(const __attribute__((address_space(3))) bf16x8*)(kp+2560);
  kf[4]=*(const __attribute__((address_space(3))) bf16x8*)(kp+4096); kf[5]=*(const __attribute__((address_space(3))) bf16x8*)(kp+4608);
  kf[6]=*(const __attribute__((address_space(3))) bf16x8*)(kp+6144); kf[7]=*(const __attribute__((address_space(3))) bf16x8*)(kp+6656);
}
__device__ __forceinline__ void kload2(bf16x8*kf,lds_cptr kp,int j){ kf[2*j]=*(const __attribute__((address_space(3))) bf16x8*)(kp+j*2048); kf[2*j+1]=*(const __attribute__((address_space(3))) bf16x8*)(kp+j*2048+512); }
__device__ __forceinline__ s16x4 vtr(lds_cptr p){ return __builtin_bit_cast(s16x4,__builtin_amdgcn_ds_read_tr16_b64_v4i16((__attribute__((address_space(3))) v4i16_t*)p)); }
__device__ __forceinline__ float rowmax(const f32x16&p0,const f32x16&p1){
  float a=max3f(p0[0],p0[1],p1[0]),b=max3f(p0[2],p0[3],p1[1]);a=max3f(a,p1[2],p1[3]);
  #pragma unroll
  for(int r=4;r<16;r+=4){a=max3f(a,p0[r],p0[r+1]);b=max3f(b,p0[r+2],p0[r+3]);a=max3f(a,p1[r],p1[r+1]);b=max3f(b,p1[r+2],p1[r+3]);}
  const float m=max2f(a,b);
  auto rr=__builtin_amdgcn_permlane32_swap(__float_as_uint(m),__float_as_uint(m),false,false);
  return max2f(__uint_as_float(rr[0]),__uint_as_float(rr[1]));
}
__device__ __forceinline__ void pv(f32x16*o,int vb,bf16x8 pa0,bf16x8 pa1,bf16x8 pa2,bf16x8 pa3){
  #pragma unroll
  for(int d0=0;d0<2;++d0){s16x4 lo[4],hi[4];
    #pragma unroll
    for(int ks=0;ks<4;++ks){
      asm volatile("ds_read_b64_tr_b16 %0,%1 offset:%c2":"=&v"(lo[ks]):"v"(vb),"i"(d0*4096+ks*1024):"memory");
      asm volatile("ds_read_b64_tr_b16 %0,%1 offset:%c2":"=&v"(hi[ks]):"v"(vb),"i"(d0*4096+ks*1024+512):"memory");}
    asm volatile("s_waitcnt lgkmcnt(0)":::"memory");SBAR();
    #define PK(k) (bf16x8){lo[k][0],lo[k][1],lo[k][2],lo[k][3],hi[k][0],hi[k][1],hi[k][2],hi[k][3]}
    o[d0]=__builtin_amdgcn_mfma_f32_32x32x16_bf16(pa0,PK(0),o[d0],0,0,0);
    o[d0]=__builtin_amdgcn_mfma_f32_32x32x16_bf16(pa1,PK(1),o[d0],0,0,0);
    o[d0]=__builtin_amdgcn_mfma_f32_32x32x16_bf16(pa2,PK(2),o[d0],0,0,0);
    o[d0]=__builtin_amdgcn_mfma_f32_32x32x16_bf16(pa3,PK(3),o[d0],0,0,0);
    #undef PK
  }
}

#ifndef ATTN_STORE16
#define ATTN_STORE16(p,v) pg8::st16((void*)(p),(v))
#define ATTN_STORE16_PLAIN(p,v) (*(u32x4*)(p)=(v))
#endif
template<int THRL> __device__ __forceinline__ void attn_unit(int b,int h,int qb,const bf16*Q,const bf16*__restrict__ K,const bf16*__restrict__ V,bf16*O,const float*LOGF,char*shm,const int wv,const bool scan){
  const int tid=mk_ltid(wv),lane=tid&63,r32=lane&31,hi=lane>>5; const int wid=__builtin_amdgcn_readfirstlane(tid>>6);
  const long rowbase=(long)b*SEQ; const int q0=qb*QB;
  const bf16*Qw=Q+(rowbase+q0+wid*QBLK)*DM+h*D;
  const bf16*Kh=K+rowbase*DM+h*D,*Vh=V+rowbase*DM+h*D;
  const lds_cptr shm3=(lds_cptr)shm; const unsigned lds0=(unsigned)(uintptr_t)shm;
  float*wsf=(float*)(shm+LDS_WS)+wid*64;
  const bf16*ksrc=Kh+(long)lane*DM+wid*8;
  const bf16*vsrc=Vh+(long)(16*(wid&3)+(lane>>2))*DM+(wid>>2)*32+(lane&3)*8;
  const unsigned kdst=lds0+LDS_K+wid*1024, vdst=lds0+LDS_V+wid*1024;
  #define DMA_K(t,slot) glds16(ksrc+(long)(t)*KVBLK*DM,(unsigned)__builtin_amdgcn_readfirstlane(kdst+(slot)))
  #define DMA_V(t,slot) glds16(vsrc+(long)(t)*KVBLK*DM,(unsigned)__builtin_amdgcn_readfirstlane(vdst+(slot)))
  const int vb0=(int)(lds0+LDS_V)+((lane>>4)&1)*32+(lane&3)*8+(4*hi+((lane&15)>>2))*64;
  const char*Kbase=shm+LDS_K; bf16x8 kf[8];
  const lds_cptr kp0=shm3+LDS_K+hi*1024+r32*16; const lds_cptr vp0=shm3+LDS_V+((lane>>4)&1)*32+(lane&3)*8+(4*hi+((lane&15)>>2))*64;
  const int NT=(q0+QB)/KVBLK;
  if(scan){ typedef __attribute__((address_space(3))) float lf32; typedef float f32x4_t __attribute__((ext_vector_type(4)));
    lf32*cbw=(lf32*)(shm3+LDS_CB); lf32*tot=(lf32*)(shm3+LDS_WS);
    const float*lfp=LOGF+(long)(b*NHEAD+h)*SEQ; const bool act=(4*tid<SEQ);
    f32x4_t v={0.f,0.f,0.f,0.f}; if(act)v=*(const f32x4_t*)(lfp+4*tid);
    v[1]+=v[0];v[2]+=v[1];v[3]+=v[2]; float s=v[3];
    _Pragma("unroll") for(int o=1;o<64;o<<=1){const float n_=__shfl_up(s,o); if(lane>=o)s+=n_;}
    if(lane==63)tot[wid]=s;
    __syncthreads();
    float base=s-v[3]; for(int w=0;w<wid;++w)base+=tot[w];
    if(act)*(__attribute__((address_space(3))) f32x4_t*)(cbw+4*tid)=(f32x4_t){v[0]+base,v[1]+base,v[2]+base,v[3]+base};
    __syncthreads(); }
  DMA_K(0,0);DMA_V(0,0);DMA_K(1,SLOTB);
  bf16x8 qr[4];
  #pragma unroll
  for(int d0=0;d0<4;++d0)qr[d0]=__builtin_nontemporal_load(reinterpret_cast<const bf16x8*>(&Qw[(long)r32*DM+d0*16+hi*8]));
  float mhat=0.f,l_reg=0.f,nm=0.f;f32x16 o[2];o[0]=f32x16{};o[1]=f32x16{};
  typedef float f32x4_t __attribute__((ext_vector_type(4)));
  const __attribute__((address_space(3))) float* cbl=(const __attribute__((address_space(3))) float*)(shm3+LDS_CB)+4*hi;
  #define CBINIT1(C,t,off) do{ const __attribute__((address_space(3))) float* cbt_=cbl+64*(t)+(off); \
    _Pragma("unroll") for(int g_=0;g_<4;++g_){ const f32x4_t b_=*(const __attribute__((address_space(3))) f32x4_t*)(cbt_+8*g_); \
      _Pragma("unroll") for(int j_=0;j_<4;++j_){ C[4*g_+j_]=nm-b_[j_]; } } }while(0)
  #define CBINIT(C0,C1,t) do{ CBINIT1(C0,t,0); CBINIT1(C1,t,32); }while(0)
  const int qrel=wid*QBLK+r32;
  { const float cbq=((const __attribute__((address_space(3))) float*)(shm3+LDS_CB))[q0+qrel]; mhat=-cbq; nm=cbq; }
  #define CMASK(P0,P1,t) do{int jb_=(t)-(NT-4); if(jb_>=0)cmask(P0,P1,jb_,qrel,hi);}while(0)
  bool resc=false;
  #define START(P0,P1) do{ const float rm=rowmax(P0,P1); resc=false; \
    if(__any(rm>(float)THRL)){ const float dl=__builtin_fmaxf(rm,0.f); mhat=fadd_s(mhat,dl); \
      _Pragma("unroll") for(int r=0;r<16;++r){P0[r]=fsub_s(P0[r],dl);P1[r]=fsub_s(P1[r],dl);} \
      nm=-mhat; } \
    _Pragma("unroll") for(int r=0;r<16;++r)P0[r]=__builtin_amdgcn_exp2f(P0[r]); }while(0)
  #define RESC() do{ if(resc){ asm volatile("s_waitcnt lgkmcnt(0)":::"memory"); \
      _Pragma("unroll") for(int d_=0;d_<2;++d_) _Pragma("unroll") for(int r=0;r<16;++r)o[d_][r]*=wsf[crow(r,hi)]; } }while(0)
  f32x16 pA0,pA1,pB0,pB1;
  int sl_prev=0,sl_cur=0,sl_next=SLOTB;
  #define ROT() do{sl_prev=sl_cur;sl_cur=sl_next;sl_next=(sl_next==(NSLOT-1)*SLOTB)?0:sl_next+SLOTB;}while(0)
  DMA_K(2,2*SLOTB);
  WAIT_BAR(3);
  CBINIT(pA0,pA1,0); qkt(pA0,pA1,Kbase,qr,r32,hi);asm volatile("s_nop 15\n\ts_nop 7":"+v"(pA0),"+v"(pA1));CMASK(pA0,pA1,0);
  START(pA0,pA1);
  _Pragma("unroll") for(int r=0;r<16;++r)pA1[r]=__builtin_amdgcn_exp2f(pA1[r]);
  WAIT_BAR(0);
  DMA_K(3,0);DMA_V(1,SLOTB);
  ROT();
  kload8(kf,kp0+sl_cur);
  WAIT_BAR(2);
  s16x4 vlo[8],vhi[8]; u32x4 pw0,pw1,pw2,pw3;
  #define PKW(P,B) cvtpk_s(P[B],P[B+1])
  #define PAF(k) __builtin_bit_cast(bf16x8,pw##k)
  #define VFR(i) (bf16x8){vlo[i][0],vlo[i][1],vlo[i][2],vlo[i][3],vhi[i][0],vhi[i][1],vhi[i][2],vhi[i][3]}
  #define PIN(x) asm volatile("":"+v"(x))
  #define MX3(a,b,c) __builtin_fmaxf(__builtin_fmaxf((a),(b)),(c))
  #define GAPA(MF,A0,A1,A2,A3,W0,W1,PW) do{ MF; sacc+=A0; sacc+=A1; sacc+=A2; sacc+=A3; PIN(sacc); W0; W1; PIN(PW); SBAR(); }while(0)
  #define EX(v) __builtin_amdgcn_exp2f(v)
  #define GAPB(MF,X,B) do{ MF; X[B]=EX(X[B]); X[B+1]=EX(X[B+1]); X[B+2]=EX(X[B+2]); X[B+3]=EX(X[B+3]); PIN(X); SBAR(); }while(0)
  #define VRD(i) do{ vlo[i]=vtr(vp_+(((i)>>2)*4096+((i)&3)*1024)); vhi[i]=vtr(vp_+(((i)>>2)*4096+((i)&3)*1024+512)); }while(0)
  #define KRD(G,j) do{ if(G){ kload2(kf,kp0+sl_next,j); SBAR(); } }while(0)
  #define STEP(C0,C1,P0,P1,t,GK,GV,GL) do{ SBAR(); CBINIT1(C0,t,0); SBAR(); \
    const lds_cptr vp_=vp0+sl_prev; \
    VRD(0); SBAR(); float sacc=(P0[0]+P0[1]); \
    GAPA(C0=__builtin_amdgcn_mfma_f32_32x32x16_bf16(kf[0],qr[0],C0,0,0,0), P0[2],P0[3],P0[4],P0[5],     pw0[0]=PKW(P0,0), pw0[1]=PKW(P0,2), pw0); \
    CBINIT1(C1,t,32); VRD(4); SBAR(); GAPA(C1=__builtin_amdgcn_mfma_f32_32x32x16_bf16(kf[1],qr[0],C1,0,0,0), P0[6],P0[7],P0[8],P0[9],     pw0[2]=PKW(P0,4), pw0[3]=PKW(P0,6), pw0); \
    VRD(1); SBAR(); GAPA(C0=__builtin_amdgcn_mfma_f32_32x32x16_bf16(kf[2],qr[1],C0,0,0,0),   P0[10],P0[11],P0[12],P0[13], pw1[0]=PKW(P0,8), pw1[1]=PKW(P0,10), pw1); \
    VRD(5); SBAR(); GAPA(C1=__builtin_amdgcn_mfma_f32_32x32x16_bf16(kf[3],qr[1],C1,0,0,0),   P0[14],P0[15],P1[0],P1[1],   pw1[2]=PKW(P0,12),pw1[3]=PKW(P0,14), pw1); \
    VRD(2); SBAR(); GAPA(C0=__builtin_amdgcn_mfma_f32_32x32x16_bf16(kf[4],qr[2],C0,0,0,0),   P1[2],P1[3],P1[4],P1[5],     pw2[0]=PKW(P1,0), pw2[1]=PKW(P1,2), pw2); \
    VRD(6); SBAR(); GAPA(C1=__builtin_amdgcn_mfma_f32_32x32x16_bf16(kf[5],qr[2],C1,0,0,0),   P1[6],P1[7],P1[8],P1[9],     pw2[2]=PKW(P1,4), pw2[3]=PKW(P1,6), pw2); \
    VRD(3); SBAR(); GAPA(C0=__builtin_amdgcn_mfma_f32_32x32x16_bf16(kf[6],qr[3],C0,0,0,0),   P1[10],P1[11],P1[12],P1[13], pw3[0]=PKW(P1,8), pw3[1]=PKW(P1,10), pw3); \
    VRD(7); SBAR(); GAPA(C1=__builtin_amdgcn_mfma_f32_32x32x16_bf16(kf[7],qr[3],C1,0,0,0),   P1[14],P1[15],0.f,0.f,       pw3[2]=PKW(P1,12),pw3[3]=PKW(P1,14), pw3); \
    l_reg+=sacc; \
    if(GK){DMA_K((t)+3,sl_cur);} if(GV){DMA_V((t)+1,sl_next);} \
    CMASK(C0,C1,t); \
    { float a=MX3(C0[0],C0[1],C1[0]),b=MX3(C0[2],C0[3],C1[1]); a=MX3(a,C1[2],C1[3]); \
      _Pragma("unroll") for(int r=4;r<16;r+=4){a=MX3(a,C0[r],C0[r+1]);b=MX3(b,C0[r+2],C0[r+3]);a=MX3(a,C1[r],C1[r+1]);b=MX3(b,C1[r+2],C1[r+3]);} \
      float rm=__builtin_fmaxf(a,b); { auto rr=__builtin_amdgcn_permlane32_swap(__float_as_uint(rm),__float_as_uint(rm),false,false); rm=__builtin_fmaxf(__uint_as_float(rr[0]),__uint_as_float(rr[1])); } \
      resc=false; \
      if(__builtin_expect(__any(rm>(float)THRL),0)){ const float dl=__builtin_fmaxf(rm,0.f); mhat+=dl; \
        _Pragma("unroll") for(int r=0;r<16;++r){C0[r]-=dl;C1[r]-=dl;} \
        nm=-mhat; \
        const float f=__builtin_amdgcn_exp2f(-dl); l_reg*=f; if(hi==0)wsf[r32]=f; resc=true; } } \
    SBAR(); \
    GAPB(o[0]=__builtin_amdgcn_mfma_f32_32x32x16_bf16(PAF(0),VFR(0),o[0],0,0,0), C0,0); \
    GAPB(o[1]=__builtin_amdgcn_mfma_f32_32x32x16_bf16(PAF(0),VFR(4),o[1],0,0,0), C0,4); \
    KRD(GL,0); GAPB(o[0]=__builtin_amdgcn_mfma_f32_32x32x16_bf16(PAF(1),VFR(1),o[0],0,0,0), C0,8); \
    KRD(GL,1); GAPB(o[1]=__builtin_amdgcn_mfma_f32_32x32x16_bf16(PAF(1),VFR(5),o[1],0,0,0), C0,12); \
    KRD(GL,2); GAPB(o[0]=__builtin_amdgcn_mfma_f32_32x32x16_bf16(PAF(2),VFR(2),o[0],0,0,0), C1,0); \
    KRD(GL,3); GAPB(o[1]=__builtin_amdgcn_mfma_f32_32x32x16_bf16(PAF(2),VFR(6),o[1],0,0,0), C1,4); \
    GAPB(o[0]=__builtin_amdgcn_mfma_f32_32x32x16_bf16(PAF(3),VFR(3),o[0],0,0,0), C1,8); \
    GAPB(o[1]=__builtin_amdgcn_mfma_f32_32x32x16_bf16(PAF(3),VFR(7),o[1],0,0,0), C1,12); \
    }while(0)
  int t=1;
  #undef CMASK
  #define CMASK(P0,P1,t) do{}while(0)
  for(;t+5<NT;t+=2){
    STEP(pB0,pB1,pA0,pA1,t,true,true,true);     WAIT_BAR(2); RESC(); ROT();
    STEP(pA0,pA1,pB0,pB1,t+1,true,true,true);   WAIT_BAR(2); RESC(); ROT();
  }
  #undef CMASK
  #define CMASK(P0,P1,t) do{int jb_=(t)-(NT-4); if(jb_>=0)cmask(P0,P1,jb_,qrel,hi);}while(0)
  #define ENDW(tt) do{ if((tt)+3<NT){WAIT_BAR(2);} else if((tt)+2<NT){WAIT_BAR(1);} else {WAIT_BAR(0);} }while(0)
  for(;t+1<NT;t+=2){
    STEP(pB0,pB1,pA0,pA1,t,(t+3<NT),(t+1<NT),(t+1<NT));       ENDW(t);   RESC(); ROT();
    STEP(pA0,pA1,pB0,pB1,t+1,(t+4<NT),(t+2<NT),(t+2<NT));     ENDW(t+1); RESC(); ROT();
  }
  STEP(pB0,pB1,pA0,pA1,NT-1,false,false,false); RESC();
  { float sacc=pB0[0]+pB0[1]; _Pragma("unroll") for(int r=2;r<16;++r)sacc+=pB0[r]; _Pragma("unroll") for(int r=0;r<16;++r)sacc+=pB1[r]; l_reg+=sacc;
    pw0=(u32x4){PKW(pB0,0),PKW(pB0,2),PKW(pB0,4),PKW(pB0,6)};pw1=(u32x4){PKW(pB0,8),PKW(pB0,10),PKW(pB0,12),PKW(pB0,14)};pw2=(u32x4){PKW(pB1,0),PKW(pB1,2),PKW(pB1,4),PKW(pB1,6)};pw3=(u32x4){PKW(pB1,8),PKW(pB1,10),PKW(pB1,12),PKW(pB1,14)};
    SBAR(); pv(o,vb0+sl_cur,PAF(0),PAF(1),PAF(2),PAF(3)); }
  #undef PKW
  #undef PAF
  #undef VFR
  #undef PIN
  #undef MX3
  #undef GAPA
  #undef GAPB
  #undef EX
  #undef VRD
  #undef KRD
  #undef STEP
  #undef ENDW
  {auto rr=__builtin_amdgcn_permlane32_swap(__float_as_uint(l_reg),__float_as_uint(l_reg),false,false);l_reg=__uint_as_float(rr[0])+__uint_as_float(rr[1]);}
  if(hi==0)wsf[32+r32]=l_reg;asm volatile("s_waitcnt lgkmcnt(0)":::"memory");
  float rli[16];
  #pragma unroll
  for(int r=0;r<16;++r)rli[r]=__builtin_amdgcn_rcpf(wsf[32+crow(r,hi)]);
  bf16*Ow=O+(rowbase+q0+wid*QBLK)*DM+h*D;
  { bf16*stg=(bf16*)(shm+LDS_OST)+wid*2048;
    #pragma unroll
    for(int r=0;r<16;++r){const int orow=crow(r,hi);
      #pragma unroll
      for(int d0=0;d0<2;++d0)stg[orow*64+d0*32+r32]=__float2bfloat16(o[d0][r]*rli[r]);}
    asm volatile("s_waitcnt lgkmcnt(0)":::"memory");
    #pragma unroll
    for(int i=0;i<4;++i){const int row=i*8+(lane>>3),ch=lane&7; const u32x4 v=*(const u32x4*)(stg+row*64+ch*8); ATTN_STORE16(Ow+(long)row*DM+ch*8,v);} }
  asm volatile("s_waitcnt lgkmcnt(0)\n\ts_barrier":::"memory");
  #undef DMA_K
  #undef DMA_V
  #undef CMASK
  #undef START
  #undef RESC
  #undef ROT
  #undef CBINIT
  #undef CBINIT1
}
constexpr int ATTN_LDS_BYTES=LDS_BYTES;
struct AttnTensors { const bf16* Q; const bf16* K; const bf16* V; bf16* O; const float* LOGF; };
struct AttnUnit { int bh; int qb; };
struct StaticOrder {
  int vcu,G;
  __device__ __forceinline__ explicit StaticOrder(int grid,int block):vcu((grid%8==0)?(block%8)*(grid/8)+block/8:block),G(grid){}
  __device__ __forceinline__ bool next(int i,AttnUnit&u)const{
    if(G==256){ if(i>=4)return false; const int s=vcu&1; u.bh=vcu>>1; u.qb=(i==0)?7-s:(i==1)?s:(i==2)?4+s:3-s; return true; }
    const int idx=vcu+i*G; if(idx>=BATCH*NHEAD*NQB)return false; u.bh=idx/NQB; u.qb=NQB-1-(idx%NQB); return true; }
  __device__ __forceinline__ void a_ready(const AttnUnit&)const{}
  __device__ __forceinline__ void done(const AttnUnit&)const{}
};
template<class Sched,int THRL=8> __device__ __forceinline__ void attn_phase(char*lds,const AttnTensors&T,const Sched&S,const int wv){
  AttnUnit u;
  int last_bh=-1;
  for(int i=0;S.next(i,u);++i){ S.a_ready(u); attn_unit<THRL>(u.bh/NHEAD,u.bh%NHEAD,u.qb,T.Q,T.K,T.V,T.O,T.LOGF,lds,wv,u.bh!=last_bh); last_bh=u.bh; S.done(u); }
}
#undef SBAR
#undef WAIT_BAR
}

namespace cg = cooperative_groups;
constexpr int NWAVES = 8;
constexpr int BATCH = 8, SEQ = 2048, D = 1024, M = BATCH * SEQ, DEPTH = 4, DFF = 2816;
constexpr float EPS = 1e-6f, LOG2E = 1.4426950408889634f;
constexpr size_t MiB = 1u << 20;
constexpr size_t WS_SSQ = 1 * MiB;
constexpr size_t WS_LOGF = 2 * MiB;
constexpr size_t WS_IG = 3 * MiB, WS_LF = 3 * MiB + 512 * 1024;
constexpr size_t WS_NS = 4 * MiB;
constexpr size_t WS_MS = 5 * MiB;
constexpr size_t WS_LNP = 6 * MiB;
constexpr size_t WS_WG = 10 * MiB;
constexpr size_t WS_WM = 10 * MiB + 512 * 1024;
constexpr size_t WS_W = 12 * MiB;
constexpr size_t W_AIN = 0, W_AOUT = 12 * MiB, W_BIN = 16 * MiB, W_BOUT = 24 * MiB, W_CIN = 26 * MiB, W_COUT = 34 * MiB, W_GU = 38 * MiB, W_DN = 82 * MiB;
constexpr size_t SZ_AIN = 6 * MiB, SZ_AOUT = 2 * MiB, SZ_GU = 11 * MiB, SZ_DN = (size_t)1024 * 2816 * 2;
constexpr size_t WS_XB = 116 * MiB;
constexpr size_t WS_S1 = 148 * MiB, WS_S2 = 180 * MiB;
constexpr size_t WS_PROJ = 212 * MiB;
constexpr size_t WS_END = 340 * MiB;
constexpr int LDSCTL_OFF = 131072;
constexpr int CW_PANEL = 8192;
constexpr int CW_BAR = 4096;
constexpr size_t CTL_ZERO_BYTES = 64 * 1024;
constexpr int LDS_BYTES = 147456;

#define LAS __attribute__((address_space(3)))
typedef unsigned short bf16;
typedef float f32x4 __attribute__((ext_vector_type(4)));
typedef float f32x2 __attribute__((ext_vector_type(2)));
typedef float f32x16 __attribute__((ext_vector_type(16)));
typedef short bf16x8 __attribute__((ext_vector_type(8)));
typedef unsigned u32x4 __attribute__((ext_vector_type(4)));
typedef unsigned u32x2 __attribute__((ext_vector_type(2)));
typedef LAS unsigned char* ldsp;
__device__ __forceinline__ unsigned pk2(float lo, float hi) { return pg8::pkbf(lo, hi); }
__device__ __forceinline__ float bf2f(unsigned short h) { return __uint_as_float((unsigned)h << 16); }
__device__ __forceinline__ float bflo(unsigned w) { return __uint_as_float(w << 16); }
__device__ __forceinline__ float bfhi(unsigned w) { return __uint_as_float(w & 0xffff0000u); }
__device__ __forceinline__ float wave_sum(float v) {
#pragma unroll
    for (int o = 1; o < 64; o <<= 1) v += __shfl_xor(v, o);
    return v;
}
__device__ __forceinline__ float log_sigmoid(float x) { return fminf(x, 0.f) - log1pf(expf(-fabsf(x))); }
__device__ __forceinline__ float sigmoid_f(float x) { return __builtin_amdgcn_rcpf(1.0f + __builtin_amdgcn_exp2f(-LOG2E * x)); }
__device__ __forceinline__ float exp_f(float x) { return __builtin_amdgcn_exp2f(LOG2E * x); }
#define LDS_BARRIER() asm volatile("s_waitcnt lgkmcnt(0)\n\ts_barrier" ::: "memory")
#define MFMA32(a, b, c) __builtin_amdgcn_mfma_f32_32x32x16_bf16(a, b, c, 0, 0, 0)

#define XB_TMO      128
#define XB_XCNT(j)  (256  + 64 * (j))
#define XB_XSUB(j)  (1280 + 64 * (j))
#define XB_XGEN(j)  (2304 + 64 * (j))
#define XB_TOP      3328
#define XB_TOPGEN   3392
#define XCD_BAR_WORDS 3456
#define XB_SPIN_CAP (1u << 18)

__device__ __forceinline__ unsigned xb_ld(unsigned* p)              { return __hip_atomic_load(p, __ATOMIC_RELAXED, __HIP_MEMORY_SCOPE_AGENT); }
__device__ __forceinline__ unsigned xb_add(unsigned* p, unsigned v) { return __hip_atomic_fetch_add(p, v, __ATOMIC_RELAXED, __HIP_MEMORY_SCOPE_AGENT); }
__device__ __forceinline__ unsigned xb_xcc_id() { return (unsigned)__builtin_amdgcn_s_getreg((3 << 11) | 20) & 0xFu; }
#define XB_SPIN(cond, bar) do { unsigned _sp = 0; while (cond) { __builtin_amdgcn_s_sleep(1); \
    if ((++_sp & 255u) == 0u) { if (xb_ld(&(bar)[XB_TMO])) break; if (_sp > XB_SPIN_CAP) { atomicAdd(&(bar)[XB_TMO], 1u); break; } } } } while (0)

struct XcdBarrier {
    unsigned* bar; unsigned x;
    volatile LAS unsigned* st;
};

__device__ __forceinline__ XcdBarrier xcd_barrier_post(unsigned* bar, volatile LAS unsigned* st, int tid) {
    XcdBarrier b; b.bar = bar; b.x = xb_xcc_id(); b.st = st;
    if (tid == 0) (void)xb_add(&bar[XB_XCNT(b.x)], 1u);
    return b;
}
__device__ __forceinline__ void xcd_barrier_complete(unsigned* bar, unsigned x, unsigned& nloc, unsigned& nx) {
    const unsigned G = gridDim.x * gridDim.y * gridDim.z;
    unsigned sum, cnt, mine, sp = 0u;
    for (;;) {
        sum = 0u; cnt = 0u; mine = 0u;
        unsigned cv[16];
#pragma unroll
        for (unsigned j = 0; j < 16; ++j) asm volatile("global_load_dword %0, %1, off sc1" : "=v"(cv[j]) : "v"(&bar[XB_XCNT(j)]) : "memory");
        asm volatile("s_waitcnt vmcnt(0)" : "+v"(cv[0]), "+v"(cv[1]), "+v"(cv[2]), "+v"(cv[3]), "+v"(cv[4]), "+v"(cv[5]), "+v"(cv[6]), "+v"(cv[7]), "+v"(cv[8]), "+v"(cv[9]), "+v"(cv[10]), "+v"(cv[11]), "+v"(cv[12]), "+v"(cv[13]), "+v"(cv[14]), "+v"(cv[15]) :: "memory");
#pragma unroll
        for (unsigned j = 0; j < 16; ++j) { const unsigned c = cv[j]; sum += c; cnt += (c > 0u) ? 1u : 0u; mine = (j == x) ? c : mine; }
        if (sum == G) break;
        __builtin_amdgcn_s_sleep(1);
        if ((++sp & 255u) == 0u) { if (xb_ld(&bar[XB_TMO])) break; if (sp > XB_SPIN_CAP) { atomicAdd(&bar[XB_TMO], 1u); break; } }
    }
    nloc = mine > 0u ? mine : 1u; nx = cnt > 0u ? cnt : 1u;
}

#ifndef XB_EARLY_INV
#define XB_EARLY_INV 1
#endif
#ifndef XB_DIRECT_RELEASE
#define XB_DIRECT_RELEASE 0
#endif
struct BPre { const bf16* Bt; int K, pn; ldsp lds; };
__device__ __forceinline__ void xcd_barrier(const XcdBarrier& b, int tid, const BPre bp = BPre{nullptr, 0, 0, nullptr}) {
    asm volatile("s_waitcnt vmcnt(0)" ::: "memory");
    __syncthreads();
#if XB_EARLY_INV
    if (tid == 64) asm volatile("buffer_inv sc1" ::: "memory");
#endif
    if (bp.Bt != nullptr && tid >= 256) pg8::prestage_b<true>(bp.lds, (const pg8::bf16_t*)bp.Bt, bp.K, bp.pn, __builtin_amdgcn_readfirstlane(tid >> 6), tid & 63);
    if (tid == 0) {
        unsigned* bar = b.bar;
        __builtin_amdgcn_s_waitcnt(0);
        unsigned nloc = b.st[0], nx = b.st[1];
        if (nloc == 0u) { xcd_barrier_complete(bar, b.x, nloc, nx); b.st[0] = nloc; b.st[1] = nx; }
        const unsigned old = xb_add(&bar[XB_XSUB(b.x)], 1u);
        const unsigned gen = old / nloc;
        if (old + 1u == (gen + 1u) * nloc) {
            __builtin_amdgcn_fence(__ATOMIC_RELEASE, "agent");
            asm volatile("s_waitcnt vmcnt(0)" ::: "memory");
            const unsigned og = xb_add(&bar[XB_TOP], 1u);
            const unsigned tg = og / nx;
#if XB_DIRECT_RELEASE
            if (og + 1u == (tg + 1u) * nx) {
#pragma unroll
                for (unsigned j = 0; j < 16; ++j) (void)xb_add(&bar[XB_XGEN(j)], 1u);
            } else XB_SPIN(xb_ld(&bar[XB_XGEN(b.x)]) == gen, bar);
            asm volatile("s_waitcnt vmcnt(0)" ::: "memory");
#else
            if (og + 1u != (tg + 1u) * nx) XB_SPIN(xb_ld(&bar[XB_TOP]) < (tg + 1u) * nx, bar);
#if !XB_EARLY_INV
            __builtin_amdgcn_fence(__ATOMIC_ACQUIRE, "agent");
#endif
            xb_add(&bar[XB_XGEN(b.x)], 1u);
            asm volatile("s_waitcnt vmcnt(0)" ::: "memory");
#endif
        } else {
            XB_SPIN(xb_ld(&bar[XB_XGEN(b.x)]) == gen, bar);
#if !XB_EARLY_INV
            __builtin_amdgcn_fence(__ATOMIC_ACQUIRE, "agent");
#endif
            asm volatile("s_waitcnt vmcnt(0)" ::: "memory");
        }
    }
#if XB_EARLY_INV
    if (tid == 64) asm volatile("s_waitcnt vmcnt(0)" ::: "memory");
#endif
    if (tid >= 256) asm volatile("s_waitcnt vmcnt(0)" ::: "memory");
    __syncthreads();
}

struct Frame {
    ldsp lds; int tid, lane, wave, vcu, G;
    const float* const* inp; float* out; unsigned char* ws;
    __device__ __forceinline__ const float* in_(int i) const { asm volatile("" : "+s"(i)); return inp[i]; }
};

struct P0Job { const float* W; const float* gain; bf16* WT; int ldw, K, n0, dst, kb; };
__device__ __forceinline__ void p0_set(P0Job& j, const float* W, int ldw, int K, int N, bf16* WT, const float* gain, int r, bool gu) {
    const int nblk = N / 32, kb = r / nblk, nb = r % nblk; const int n0 = 32 * nb; int dst = n0;
    if (gu) { if (n0 < DFF) dst = 256 * (n0 / 128) + (n0 % 128); else { const int n1 = n0 - DFF; dst = 256 * (n1 / 128) + 128 + (n1 % 128); } }
    j.W = W; j.gain = gain; j.WT = WT; j.ldw = ldw; j.K = K; j.n0 = n0; j.dst = dst; j.kb = kb;
}
constexpr int P0_I_AIN = 16 * 96, P0_I_SQ = 16 * 32, P0_I_BIN = 16 * 128, P0_I_COUT = 32 * 32, P0_I_GU = 16 * 176, P0_I_DN = 44 * 32;
constexpr int P0_MIX = 2 * P0_I_AIN + 2 * P0_I_SQ + P0_I_BIN + P0_I_SQ + P0_I_BIN + P0_I_COUT, P0_FFN = P0_I_GU + P0_I_DN;
__device__ __forceinline__ void p0_decode(Frame& F, int it, P0Job& j, int mode, bool all_ffn) {
    bf16* WB = (bf16*)(F.ws + WS_W); const float* n1g = F.in_(1); const float* n2g = F.in_(2);
    constexpr int I_AIN = P0_I_AIN, I_SQ = P0_I_SQ, I_BIN = P0_I_BIN, I_GU = P0_I_GU, I_DN = P0_I_DN;
    int r = it;
    if (mode > 0) { const int i = mode;
        if (r < I_GU) { p0_set(j, F.in_(20) + (size_t)i * D * 2 * DFF, 2 * DFF, D, 2 * DFF, (bf16*)((char*)WB + W_GU + i * SZ_GU), n2g + i * D, r, true); return; } r -= I_GU;
        if (r < I_DN) { p0_set(j, F.in_(21) + (size_t)i * DFF * D, D, DFF, D, (bf16*)((char*)WB + W_DN + i * SZ_DN), nullptr, r, false); return; } r -= I_DN;
        if (i == 1) { if (r < I_BIN) { p0_set(j, F.in_(7), 4112, D, 4096, (bf16*)((char*)WB + W_BIN), n1g + 1 * D, r, false); return; } r -= I_BIN; p0_set(j, F.in_(13), D, D, D, (bf16*)((char*)WB + W_BOUT), nullptr, r, false); return; }
        if (i == 2) { if (r < I_BIN) { p0_set(j, F.in_(14), 4096, D, 4096, (bf16*)((char*)WB + W_CIN), n1g + 2 * D, r, false); return; } r -= I_BIN; p0_set(j, F.in_(19), D, 2048, D, (bf16*)((char*)WB + W_COUT), nullptr, r, false); return; }
        if (r < I_AIN) { p0_set(j, F.in_(4) + (size_t)1 * D * 3088, 3088, D, 3072, (bf16*)((char*)WB + W_AIN + 1 * SZ_AIN), n1g + 3 * D, r, false); return; } r -= I_AIN;
        p0_set(j, F.in_(6) + (size_t)1 * D * D, D, D, D, (bf16*)((char*)WB + W_AOUT + 1 * SZ_AOUT), nullptr, r, false); return; }
    if (!all_ffn) {
        if (r < I_GU) { p0_set(j, F.in_(20), 2 * DFF, D, 2 * DFF, (bf16*)((char*)WB + W_GU), n2g, r, true); return; } r -= I_GU;
        if (r < I_DN) { p0_set(j, F.in_(21), D, DFF, D, (bf16*)((char*)WB + W_DN), nullptr, r, false); return; } r -= I_DN;
        if (r < I_AIN) { p0_set(j, F.in_(4), 3088, D, 3072, (bf16*)((char*)WB + W_AIN), n1g, r, false); return; } r -= I_AIN;
        p0_set(j, F.in_(6), D, D, D, (bf16*)((char*)WB + W_AOUT), nullptr, r, false); return; }
    const int nf = all_ffn ? 4 : 1;
    if (r < nf * I_GU) { const int i = r / I_GU; p0_set(j, F.in_(20) + (size_t)i * D * 2 * DFF, 2 * DFF, D, 2 * DFF, (bf16*)((char*)WB + W_GU + i * SZ_GU), n2g + i * D, r % I_GU, true); return; } r -= nf * I_GU;
    if (r < nf * I_DN) { const int i = r / I_DN; p0_set(j, F.in_(21) + (size_t)i * DFF * D, D, DFF, D, (bf16*)((char*)WB + W_DN + i * SZ_DN), nullptr, r % I_DN, false); return; } r -= nf * I_DN;
    if (r < 2 * I_AIN) { const int i = r / I_AIN; p0_set(j, F.in_(4) + (size_t)i * D * 3088, 3088, D, 3072, (bf16*)((char*)WB + W_AIN + i * SZ_AIN), n1g + (3 * i) * D, r % I_AIN, false); return; } r -= 2 * I_AIN;
    if (r < 2 * I_SQ) { const int i = r / I_SQ; p0_set(j, F.in_(6) + (size_t)i * D * D, D, D, D, (bf16*)((char*)WB + W_AOUT + i * SZ_AOUT), nullptr, r % I_SQ, false); return; } r -= 2 * I_SQ;
    if (r < I_BIN) { p0_set(j, F.in_(7), 4112, D, 4096, (bf16*)((char*)WB + W_BIN), n1g + 1 * D, r, false); return; } r -= I_BIN;
    if (r < I_SQ) { p0_set(j, F.in_(13), D, D, D, (bf16*)((char*)WB + W_BOUT), nullptr, r, false); return; } r -= I_SQ;
    if (r < I_BIN) { p0_set(j, F.in_(14), 4096, D, 4096, (bf16*)((char*)WB + W_CIN), n1g + 2 * D, r, false); return; } r -= I_BIN;
    p0_set(j, F.in_(19), D, 2048, D, (bf16*)((char*)WB + W_COUT), nullptr, r, false);
}
__device__ __forceinline__ void p0_load(const P0Job& j, int lane, f32x4 (&w)[8], float (&gk)[8]) {
    const int kr = lane >> 3, n4 = (lane & 7) * 4;
    { const bool hg = (j.gain != nullptr); const float* gp = hg ? j.gain + 64 * j.kb + kr : j.W;
#pragma unroll
      for (int i = 0; i < 8; ++i) { const float v = gp[hg ? 8 * i : 0]; gk[i] = hg ? v : 1.0f; } }
    const float* wp = j.W + (size_t)(64 * j.kb + kr) * j.ldw + j.n0 + n4; const size_t wst = (size_t)8 * j.ldw;
#pragma unroll
    for (int i = 0; i < 8; ++i) w[i] = __builtin_nontemporal_load((const f32x4*)(wp + i * wst));
}
__device__ __forceinline__ void p0_finish(const P0Job& j, int lane, const f32x4 (&w)[8], const float (&gk)[8], LAS float* scr) {
    const int k0 = 64 * j.kb, kr = lane >> 3, n4 = (lane & 7) * 4;
#pragma unroll
    for (int i = 0; i < 8; ++i) { LAS float* sp = scr + (8 * i + kr) * 33 + n4; sp[0] = w[i][0] * gk[i]; sp[1] = w[i][1] * gk[i]; sp[2] = w[i][2] * gk[i]; sp[3] = w[i][3] * gk[i]; }
    asm volatile("s_waitcnt lgkmcnt(0)" ::: "memory");
    const int c = lane & 7;
#pragma unroll
    for (int jj = 0; jj < 4; ++jj) { const int n = (lane >> 3) + 8 * jj; const LAS float* s = scr + (8 * c) * 33 + n;
        u32x4 o; o.x = pk2(s[0 * 33], s[1 * 33]); o.y = pk2(s[2 * 33], s[3 * 33]); o.z = pk2(s[4 * 33], s[5 * 33]); o.w = pk2(s[6 * 33], s[7 * 33]);
        pg8::st16(j.WT + (size_t)(j.dst + n) * j.K + k0 + 8 * c, o); }
    asm volatile("s_waitcnt lgkmcnt(0)" ::: "memory");
}
__device__ __forceinline__ void p0_convert(Frame& F, int mode, bool all_ffn, int gw, int NGW, int nitems) {
    LAS float* scr = (LAS float*)(F.lds + F.wave * 16384); const int lane = F.lane;
    if (gw < nitems) {
        int it = gw; P0Job j0; f32x4 w0[8]; float g0[8]; p0_decode(F, it, j0, mode, all_ffn); p0_load(j0, lane, w0, g0);
        for (;;) { const int nx = it + NGW; const bool has = nx < nitems; P0Job j1 = j0; f32x4 w1[8]; float g1[8];
            if (has) { p0_decode(F, nx, j1, mode, all_ffn); p0_load(j1, lane, w1, g1); }
            p0_finish(j0, lane, w0, g0, scr);
            if (!has) break;
            j0 = j1; it = nx;
#pragma unroll
            for (int i = 0; i < 8; ++i) { w0[i] = w1[i]; g0[i] = g1[i]; } }
    }
}
__device__ __forceinline__ void p0_prologue(Frame& F) {
    const int gw = F.vcu * NWAVES + F.wave, NGW = F.G * NWAVES, lane = F.lane;
    const float* n1g = F.in_(1);
    const bool all_ffn = (F.G != 256);
    p0_convert(F, -1, all_ffn, gw, NGW, all_ffn ? P0_MIX + 4 * P0_FFN : P0_FFN + P0_I_AIN + P0_I_SQ);
    { bf16* WG = (bf16*)(F.ws + WS_WG); const int gt = blockIdx.x * (NWAVES * 64) + F.tid, NT = F.G * NWAVES * 64;
      for (int e = gt; e < 3 * 16 * 1024; e += NT) { const int g = e / 16384, n = (e >> 10) & 15, k = e & 1023;
          const float* W = (g < 2) ? F.in_(4) + (size_t)g * D * 3088 : F.in_(7); const int ldw = (g < 2) ? 3088 : 4112, c0 = (g < 2) ? 3072 : 4096;
          const float gn = n1g[((g < 2) ? 3 * g : 1) * D + k];
          WG[e] = (bf16)(pk2(W[(size_t)k * ldw + c0 + n] * gn, 0.f) & 0xffffu); }
      bf16* WM = (bf16*)(F.ws + WS_WM);
      for (int e = gt; e < 8 * 128 * 128; e += NT) { const int t = (e >> 7) & 127, s = e & 127; WM[e] = (bf16)(((t >> 6) >= (s >> 6)) ? (pk2(F.in_(17)[e], 0.f) & 0xffffu) : 0u); } }
    { float* ssq = (float*)(F.ws + WS_SSQ); bf16* XB = (bf16*)(F.ws + WS_XB);
      const float* x0 = F.in_(0);
      for (int mb = gw; mb < M; mb += 4 * NGW) { f32x4 v[4][4];
#pragma unroll
          for (int k = 0; k < 4; ++k) { const int m = mb + k * NGW;
              if (m < M) {
#pragma unroll
                  for (int j = 0; j < 4; ++j) v[k][j] = __builtin_nontemporal_load((const f32x4*)(x0 + (size_t)m * D) + lane + 64 * j); } }
          __builtin_amdgcn_sched_barrier(0);
#pragma unroll
          for (int k = 0; k < 4; ++k) { const int m = mb + k * NGW;
              if (m < M) { unsigned long long* o8 = (unsigned long long*)(XB + (size_t)m * D) + lane; float s = 0.f;
#pragma unroll
                  for (int j = 0; j < 4; ++j) { const unsigned w0 = pk2(v[k][j][0], v[k][j][1]), w1 = pk2(v[k][j][2], v[k][j][3]);
                      s += (bflo(w0) * bflo(w0) + bfhi(w0) * bfhi(w0)) + (bflo(w1) * bflo(w1) + bfhi(w1) * bfhi(w1));
                      o8[64 * j] = (unsigned long long)w0 | ((unsigned long long)w1 << 32); }
                  s = wave_sum(s);
                  if (lane < 16) ssq[(size_t)m * 16 + lane] = (lane == 0) ? s : 0.f; } } } }
}


constexpr int RS_OFF = LDSCTL_OFF + 1024;
__device__ __forceinline__ void fill_rstd(Frame& F, const pg8::StaticOrder& S, const float* ssq) {
    LAS float* RS = (LAS float*)(F.lds + RS_OFF); pg8::Unit u;
    for (int i = 0; S.next(i, u); ++i) if (F.tid < 256) { const f32x4* sp = (const f32x4*)(ssq + (size_t)(u.pm * 256 + F.tid) * 16); const f32x4 s0 = sp[0], s1 = sp[1], s2 = sp[2], s3 = sp[3];
        const float ss = ((s0[0] + s0[1]) + (s0[2] + s0[3])) + ((s1[0] + s1[1]) + (s1[2] + s1[3])) + ((s2[0] + s2[1]) + (s2[2] + s2[3])) + ((s3[0] + s3[1]) + (s3[2] + s3[3]));
        RS[i * 256 + F.tid] = 1.0f / sqrtf(ss * (1.0f / 1024.0f) + EPS); }
    __syncthreads();
}

struct RstdPre {
    const pg8::StaticOrder* S; const float* ssq; LAS float* RS; f32x4 v[3][4]; int nu;
    __device__ __forceinline__ void issue(int tid) { pg8::Unit u; nu = 0;
#pragma unroll
        for (int k = 0; k < 3; ++k) { const int i = 2 * k + (tid >> 8); if (S->next(i, u)) { const f32x4* sp = (const f32x4*)(ssq + (size_t)(u.pm * 256 + (tid & 255)) * 16); v[k][0] = sp[0]; v[k][1] = sp[1]; v[k][2] = sp[2]; v[k][3] = sp[3]; nu = k + 1; } } }
    __device__ __forceinline__ void finish(int tid) {
#pragma unroll
        for (int k = 0; k < 3; ++k) if (k < nu) { const f32x4 s0 = v[k][0], s1 = v[k][1], s2 = v[k][2], s3 = v[k][3];
            const float ss = ((s0[0] + s0[1]) + (s0[2] + s0[3])) + ((s1[0] + s1[1]) + (s1[2] + s1[3])) + ((s2[0] + s2[1]) + (s2[2] + s2[3])) + ((s3[0] + s3[1]) + (s3[2] + s3[3]));
            RS[(2 * k + (tid >> 8)) * 256 + (tid & 255)] = 1.0f / sqrtf(ss * (1.0f / 1024.0f) + EPS); } }
};
template <int KIND>
__device__ __forceinline__ void gate_items(Frame& F, const bf16* XB, const bf16* WG, const float* ssq, const float* bias0, const float* bias1, float* out0, float* out1) {
    const int lane = F.lane, wave = F.wave; LAS f32x4* XS = (LAS f32x4*)F.lds;
    for (int it0 = 0; it0 < M / 16; it0 += 4 * F.G) {
        const int g = lane & 15, kq = lane >> 4, kc = wave * 128 + kq * 8;
        bf16x8 bv[4], av[4][4];
#pragma unroll
        for (int ks = 0; ks < 4; ++ks) bv[ks] = *(const bf16x8*)(WG + (size_t)g * D + kc + ks * 32);
#pragma unroll
        for (int rb = 0; rb < 4; ++rb) { const int it = it0 + rb * F.G + F.vcu; const int r0 = ((it < M / 16) ? it : 0) * 16;
#pragma unroll
            for (int ks = 0; ks < 4; ++ks) av[rb][ks] = *(const bf16x8*)(XB + (size_t)(r0 + g) * D + kc + ks * 32); }
        const int itf = it0 + (wave & 3) * F.G + F.vcu; const bool live = (wave < 4) && (itf < M / 16); const int row0 = ((itf < M / 16) ? itf : 0) * 16, t0 = row0 + kq * 4;
        f32x4 sq[4][4]; float bz = 0.f;
        if (wave < 4) {
#pragma unroll
            for (int r = 0; r < 4; ++r) { const f32x4* sp = (const f32x4*)(ssq + (size_t)(t0 + r) * 16); sq[r][0] = sp[0]; sq[r][1] = sp[1]; sq[r][2] = sp[2]; sq[r][3] = sp[3]; }
            bz = (KIND == 0) ? bias0[g] : (g < 8) ? bias0[g] : bias1[g - 8];
        }
        __builtin_amdgcn_sched_barrier(0);
#pragma unroll
        for (int rb = 0; rb < 4; ++rb) { f32x4 acc = {0.f, 0.f, 0.f, 0.f};
#pragma unroll
            for (int ks = 0; ks < 4; ++ks) acc = __builtin_amdgcn_mfma_f32_16x16x32_bf16(av[rb][ks], bv[ks], acc, 0, 0, 0);
            XS[(rb * 8 + wave) * 64 + lane] = acc; }
        __syncthreads();
        if (live) {
            f32x4 acc = XS[(wave * 8) * 64 + lane];
#pragma unroll
            for (int w = 1; w < 8; ++w) acc += XS[(wave * 8 + w) * 64 + lane];
            const int b = t0 / SEQ, s = t0 % SEQ;
            f32x4 val;
#pragma unroll
            for (int r = 0; r < 4; ++r) { const f32x4 s0 = sq[r][0], s1 = sq[r][1], s2 = sq[r][2], s3 = sq[r][3];
                const float ss = ((s0[0] + s0[1]) + (s0[2] + s0[3])) + ((s1[0] + s1[1]) + (s1[2] + s1[3])) + ((s2[0] + s2[1]) + (s2[2] + s2[3])) + ((s3[0] + s3[1]) + (s3[2] + s3[3]));
                const float f = acc[r] * (1.0f / sqrtf(ss * (1.0f / 1024.0f) + EPS));
                if (KIND == 0) val[r] = LOG2E * log_sigmoid(f + bz);
                else val[r] = (g < 8) ? f + bz : log_sigmoid(f + bz); }
            if (KIND == 0) *(f32x4*)(out0 + (size_t)(b * 16 + g) * SEQ + s) = val;
            else { if (g < 8) *(f32x4*)(out0 + (size_t)(b * 8 + g) * SEQ + s) = val; else *(f32x4*)(out1 + (size_t)(b * 8 + g - 8) * SEQ + s) = val; }
        }
        __syncthreads();
    }
}

typedef short s16x4 __attribute__((ext_vector_type(4)));
__device__ __forceinline__ s16x4 tr16(const LAS unsigned char* p) { return __builtin_bit_cast(s16x4, __builtin_amdgcn_ds_read_tr16_b64_v4i16((LAS s16x4*)p)); }
__device__ __forceinline__ bf16x8 tr_frag(const LAS unsigned char* base, int pitch, int lane) {
    const LAS unsigned char* p = base + (8 * (lane >> 5) + ((lane & 15) >> 2)) * pitch + (16 * ((lane >> 4) & 1) + 4 * (lane & 3)) * 2;
    const s16x4 lo = tr16(p), hi = tr16(p + 4 * pitch); return (bf16x8){lo[0], lo[1], lo[2], lo[3], hi[0], hi[1], hi[2], hi[3]};
}
__device__ __forceinline__ void conv_silu8(const bf16* proj, int b, int t, int col, const float* cw, const float* cb, float scale, float (&o)[8]) {
    const f32x4 b0 = *(const f32x4*)(cb + col), b1 = *(const f32x4*)(cb + col + 4);
    float a[8] = {b0[0], b0[1], b0[2], b0[3], b1[0], b1[1], b1[2], b1[3]};
#pragma unroll
    for (int j = 0; j < 4; ++j) { const int tt = t - 3 + j;
        if (tt >= 0) { const u32x4 x = *(const u32x4*)(proj + (size_t)(b * SEQ + tt) * 4096 + col); const f32x4 w0 = *(const f32x4*)(cw + j * 2048 + col), w1 = *(const f32x4*)(cw + j * 2048 + col + 4);
            a[0] += w0[0] * bflo(x.x); a[1] += w0[1] * bfhi(x.x); a[2] += w0[2] * bflo(x.y); a[3] += w0[3] * bfhi(x.y);
            a[4] += w1[0] * bflo(x.z); a[5] += w1[1] * bfhi(x.z); a[6] += w1[2] * bflo(x.w); a[7] += w1[3] * bfhi(x.w); } }
#pragma unroll
    for (int i = 0; i < 8; ++i) o[i] = a[i] * __builtin_amdgcn_rcpf(1.0f + __builtin_amdgcn_exp2f(-LOG2E * a[i])) * scale;
}
template <int CTRL> __device__ __forceinline__ float dpp_mov(float v) { return __builtin_bit_cast(float, __builtin_amdgcn_update_dpp(0, __builtin_bit_cast(int, v), CTRL, 0xf, 0xf, false)); }
__device__ __forceinline__ float wave_scan_add(float v, int lane) {
    const int rl = lane & 15; float t;
    t = dpp_mov<0x111>(v); v = (rl >= 1) ? v + t : v;
    t = dpp_mov<0x112>(v); v = (rl >= 2) ? v + t : v;
    t = dpp_mov<0x114>(v); v = (rl >= 4) ? v + t : v;
    t = dpp_mov<0x118>(v); v = (rl >= 8) ? v + t : v;
    t = dpp_mov<0x142>(v); v = ((lane & 31) >= 16) ? v + t : v;
    t = dpp_mov<0x143>(v); v = (lane >= 32) ? v + t : v;
    return v;
}
__device__ __forceinline__ float wave_scan_max(float v, int lane) {
    const int rl = lane & 15; float t;
    t = dpp_mov<0x111>(v); v = (rl >= 1) ? fmaxf(v, t) : v;
    t = dpp_mov<0x112>(v); v = (rl >= 2) ? fmaxf(v, t) : v;
    t = dpp_mov<0x114>(v); v = (rl >= 4) ? fmaxf(v, t) : v;
    t = dpp_mov<0x118>(v); v = (rl >= 8) ? fmaxf(v, t) : v;
    t = dpp_mov<0x142>(v); v = ((lane & 31) >= 16) ? fmaxf(v, t) : v;
    t = dpp_mov<0x143>(v); v = (lane >= 32) ? fmaxf(v, t) : v;
    return v;
}
__device__ __forceinline__ float lane63(float v) { return __builtin_bit_cast(float, __builtin_amdgcn_readlane(__builtin_bit_cast(int, v), 63)); }
__device__ __forceinline__ float wave_max(float v, int lane) { return lane63(wave_scan_max(v, lane)); }
constexpr int PA_KS = 0, PA_KSB = 64 * 40 * 2, PA_VS = 2 * PA_KSB, PA_VSB = 64 * 136 * 2;
__device__ __forceinline__ void mlstm_pass_a(Frame& F, const bf16* proj, const float* IG, const float* LF, const float* cw, const float* cb, bf16* CST, float* NS, float* MS) {
    const int tid = F.tid, lane = F.lane, wave = F.wave, r32 = lane & 31, hh = lane >> 5;
    for (int u = F.vcu; u < 256; u += F.G) {
        const int bh = u >> 2, ds = u & 3, b = bh >> 3, h = bh & 7;
        const int dg = tid & 3, sk = (tid >> 2) & 63, colk = 1024 + h * 128 + ds * 32 + dg * 8;
        const int eg = tid & 15, s0 = tid >> 4, colv = 2048 + h * 128 + eg * 8;
        float wt[4][8], bs8[8];
        { const f32x4 b0 = *(const f32x4*)(cb + colk), b1 = *(const f32x4*)(cb + colk + 4);
#pragma unroll
          for (int i = 0; i < 4; ++i) { bs8[i] = b0[i]; bs8[4 + i] = b1[i]; }
#pragma unroll
          for (int j = 0; j < 4; ++j) { const f32x4 w0 = *(const f32x4*)(cw + j * 2048 + colk), w1 = *(const f32x4*)(cw + j * 2048 + colk + 4);
#pragma unroll
              for (int i = 0; i < 4; ++i) { wt[j][i] = w0[i]; wt[j][4 + i] = w1[i]; } } }
        const bf16* pk = proj + (size_t)(b * SEQ) * 4096 + colk; const bf16* pv = proj + (size_t)(b * SEQ) * 4096 + colv;
        u32x4 rkA[4], rkB[4], rkC[4], rvA[2], rvB[2], rvC[2];
#define PA_LOAD_RAW(rk, rv, c_) do { if (tid < 256) { _Pragma("unroll") for (int j_ = 0; j_ < 4; ++j_) { const int tt_ = 64 * (c_) + sk - 3 + j_; \
            rk[j_] = *(const u32x4*)(pk + (size_t)(tt_ < 0 ? 0 : tt_) * 4096); } } \
            _Pragma("unroll") for (int i_ = 0; i_ < 2; ++i_) rv[i_] = *(const u32x4*)(pv + (size_t)(64 * (c_) + s0 + 32 * i_) * 4096); } while (0)
#pragma unroll
        for (int j = 0; j < 4; ++j) { rkA[j] = (u32x4){0u, 0u, 0u, 0u}; rkB[j] = (u32x4){0u, 0u, 0u, 0u}; rkC[j] = (u32x4){0u, 0u, 0u, 0u}; }
        PA_LOAD_RAW(rkA, rvA, 0); PA_LOAD_RAW(rkB, rvB, 1);
        float lfn = LF[(size_t)bh * SEQ + lane], ign = IG[(size_t)bh * SEQ + lane], lfn2 = LF[(size_t)bh * SEQ + 64 + lane], ign2 = IG[(size_t)bh * SEQ + 64 + lane];
        f32x16 acc = {}; float mprev = 0.f;
        const bf16x8 ones = (bf16x8){0x3F80, 0x3F80, 0x3F80, 0x3F80, 0x3F80, 0x3F80, 0x3F80, 0x3F80};
#define PA_CHUNK(c, rkc, rvc, rkn, rvn) do { if ((c) < 32) { \
            const int buf = (c) & 1; \
            if ((c) + 2 < 32) PA_LOAD_RAW(rkn, rvn, (c) + 2); \
            const float lf = lfn, ig = ign; lfn = lfn2; ign = ign2; \
            if ((c) + 2 < 32) { lfn2 = LF[(size_t)bh * SEQ + 64 * ((c) + 2) + lane]; ign2 = IG[(size_t)bh * SEQ + 64 * ((c) + 2) + lane]; } \
            const float bcum = wave_scan_add(lf, lane), bL = lane63(bcum); \
            const float g = bL - bcum + ig, gmax = wave_max(g, lane), mnew = fmaxf(bL + mprev, gmax); \
            const float w = exp_f(g - mnew), decay = exp_f(bL + mprev - mnew); \
            if (wave < 4) { bf16* cp = CST + (((size_t)(bh * 32 + c) * 128 + 32 * wave + r32) * 128) + 32 * ds + 4 * hh; \
                _Pragma("unroll") for (int q = 0; q < 4; ++q) { u32x2 pk_; pk_.x = pk2(acc[4 * q], acc[4 * q + 1]); pk_.y = pk2(acc[4 * q + 2], acc[4 * q + 3]); *(u32x2*)(cp + 8 * q) = pk_; } } \
            else if (wave == 4 && r32 == 0) { float* np = NS + (size_t)(bh * 32 + c) * 128 + 32 * ds + 4 * hh; \
                _Pragma("unroll") for (int q = 0; q < 4; ++q) *(f32x4*)(np + 8 * q) = (f32x4){acc[4 * q], acc[4 * q + 1], acc[4 * q + 2], acc[4 * q + 3]}; } \
            if (tid == 0 && ds == 0) MS[bh * 32 + c] = mprev; \
            if (tid < 256) { float a[8]; \
                _Pragma("unroll") for (int ch = 0; ch < 8; ++ch) a[ch] = bs8[ch]; \
                _Pragma("unroll") for (int j = 0; j < 4; ++j) { const u32x4 x = (64 * (c) + sk - 3 + j >= 0) ? rkc[j] : (u32x4){0u, 0u, 0u, 0u};     \
                    a[0] += wt[j][0] * bflo(x.x); a[1] += wt[j][1] * bfhi(x.x); a[2] += wt[j][2] * bflo(x.y); a[3] += wt[j][3] * bfhi(x.y); \
                    a[4] += wt[j][4] * bflo(x.z); a[5] += wt[j][5] * bfhi(x.z); a[6] += wt[j][6] * bflo(x.w); a[7] += wt[j][7] * bfhi(x.w); } \
                const float ws = __shfl(w, sk) * 0.08838834764831845f; \
                _Pragma("unroll") for (int ch = 0; ch < 8; ++ch) a[ch] = a[ch] * __builtin_amdgcn_rcpf(1.0f + __builtin_amdgcn_exp2f(-LOG2E * a[ch])) * ws; \
                u32x4 o; o.x = pk2(a[0], a[1]); o.y = pk2(a[2], a[3]); o.z = pk2(a[4], a[5]); o.w = pk2(a[6], a[7]); \
                *(LAS u32x4*)(F.lds + PA_KS + buf * PA_KSB + (sk * 40 + dg * 8) * 2) = o; } \
            _Pragma("unroll") for (int i = 0; i < 2; ++i) *(LAS u32x4*)(F.lds + PA_VS + buf * PA_VSB + ((s0 + 32 * i) * 136 + eg * 8) * 2) = rvc[i]; \
            LDS_BARRIER(); \
            _Pragma("unroll") for (int r = 0; r < 16; ++r) acc[r] *= decay; \
            if (wave < 4) { \
                _Pragma("unroll") for (int ks = 0; ks < 4; ++ks) { const bf16x8 a = tr_frag(F.lds + PA_KS + buf * PA_KSB + (16 * ks * 40) * 2, 80, lane); \
                    const bf16x8 bb = tr_frag(F.lds + PA_VS + buf * PA_VSB + (16 * ks * 136 + 32 * wave) * 2, 272, lane); acc = MFMA32(a, bb, acc); } \
            } else if (wave == 4) { \
                _Pragma("unroll") for (int ks = 0; ks < 4; ++ks) { const bf16x8 a = tr_frag(F.lds + PA_KS + buf * PA_KSB + (16 * ks * 40) * 2, 80, lane); acc = MFMA32(a, ones, acc); } \
            } \
            mprev = mnew; \
        } } while (0)
        for (int c3 = 0; c3 < 32; c3 += 3) { PA_CHUNK(c3, rkA, rvA, rkC, rvC); PA_CHUNK((c3 + 1), rkB, rvB, rkA, rvA); PA_CHUNK((c3 + 2), rkC, rvC, rkB, rvB); }
#undef PA_CHUNK
#undef PA_LOAD_RAW
        LDS_BARRIER();
    }
}
constexpr int PB_QS = 0, PB_KS = 17408, PB_VT = 34816, PB_SQK = 53248, PB_HF = 62464, PB_NV = 96256, PB_MR = 96768, PB_AR = 97024, PB_EM = 97280, PB_CW = 97536, PB_CB = PB_CW + 4096, PB_NG = PB_CB + 1024;
__device__ __forceinline__ void conv8_regs(const u32x4& r0, const u32x4& r1, const u32x4& r2, const u32x4& r3, const LAS float* CW, const LAS float* CB, int m, int dg, float scale, u32x4& o) {
    const u32x4 r[4] = {r0, r1, r2, r3};
    const f32x4 b0 = *(const LAS f32x4*)(CB + m * 128 + dg * 8), b1 = *(const LAS f32x4*)(CB + m * 128 + dg * 8 + 4);
    float a[8] = {b0[0], b0[1], b0[2], b0[3], b1[0], b1[1], b1[2], b1[3]};
#pragma unroll
    for (int j = 0; j < 4; ++j) { const f32x4 w0 = *(const LAS f32x4*)(CW + (m * 4 + j) * 128 + dg * 8), w1 = *(const LAS f32x4*)(CW + (m * 4 + j) * 128 + dg * 8 + 4); const u32x4 x = r[j];
        a[0] += w0[0] * bflo(x.x); a[1] += w0[1] * bfhi(x.x); a[2] += w0[2] * bflo(x.y); a[3] += w0[3] * bfhi(x.y);
        a[4] += w1[0] * bflo(x.z); a[5] += w1[1] * bfhi(x.z); a[6] += w1[2] * bflo(x.w); a[7] += w1[3] * bfhi(x.w); }
#pragma unroll
    for (int i = 0; i < 8; ++i) a[i] = a[i] * __builtin_amdgcn_rcpf(1.0f + __builtin_amdgcn_exp2f(-LOG2E * a[i])) * scale;
    o.x = pk2(a[0], a[1]); o.y = pk2(a[2], a[3]); o.z = pk2(a[4], a[5]); o.w = pk2(a[6], a[7]);
}
__device__ __forceinline__ void mlstm_pass_b(Frame& F, const bf16* proj, const float* IG, const float* LF, const float* cw, const float* cb, const bf16* CST, const float* NS, const float* MS, const float* ng, bf16* Y) {
    const int tid = F.tid, lane = F.lane, wave = F.wave, r32 = lane & 31, hh = lane >> 5;
    LAS float* MR = (LAS float*)(F.lds + PB_MR); LAS float* AR = (LAS float*)(F.lds + PB_AR); LAS float* EM = (LAS float*)(F.lds + PB_EM); LAS float* NV = (LAS float*)(F.lds + PB_NV);
    LAS float* CW = (LAS float*)(F.lds + PB_CW); LAS float* CB = (LAS float*)(F.lds + PB_CB);
    const int dg = tid & 15, s0 = tid >> 4;
    for (int base = F.vcu * 8; base < 2048; base += F.G * 8) {
        const int bh = base >> 5, b = bh >> 3, h = bh & 7, c0 = base & 31;
        {
            float cwv[2]; float cbv = 0.f, ngv = 0.f;
#pragma unroll
            for (int q = 0; q < 2; ++q) { const int e2 = tid + q * NWAVES * 64, m = e2 >> 9, j = (e2 >> 7) & 3, ch = e2 & 127; cwv[q] = cw[j * 2048 + m * 1024 + h * 128 + ch]; }
            if (tid < 256) cbv = cb[(tid >> 7) * 1024 + h * 128 + (tid & 127)];
            if (tid >= 256 && tid < 384) ngv = ng[h * 128 + tid - 256];
#pragma unroll
            for (int q = 0; q < 2; ++q) CW[tid + q * NWAVES * 64] = cwv[q];
            if (tid < 256) CB[tid] = cbv;
            if (tid >= 256 && tid < 384) ((LAS float*)(F.lds + PB_NG))[tid - 256] = ngv; }
        LDS_BARRIER();
        const bf16* pq = proj + (size_t)(b * SEQ) * 4096 + h * 128 + dg * 8;
        const int hcol = h * 128 + 16 * (tid & 7);
        u32x4 rq[5], rk[5], rv[2]; float lfn, ign, msn, nvn = 0.f;
#define PB_LOAD_RAW(c_) do { _Pragma("unroll") for (int j_ = 0; j_ < 5; ++j_) { const int tt_ = 64 * (c_) + 2 * s0 - 3 + j_; \
              rq[j_] = (tt_ >= 0) ? *(const u32x4*)(pq + (size_t)tt_ * 4096) : (u32x4){0u, 0u, 0u, 0u}; rk[j_] = (tt_ >= 0) ? *(const u32x4*)(pq + (size_t)tt_ * 4096 + 1024) : (u32x4){0u, 0u, 0u, 0u}; } \
            _Pragma("unroll") for (int i_ = 0; i_ < 2; ++i_) rv[i_] = *(const u32x4*)(pq + (size_t)(64 * (c_) + 2 * s0 + i_) * 4096 + 2048); \
            lfn = LF[(size_t)bh * SEQ + 64 * (c_) + lane]; ign = IG[(size_t)bh * SEQ + 64 * (c_) + lane]; msn = MS[bh * 32 + (c_)]; if (tid < 128) nvn = NS[(size_t)(bh * 32 + (c_)) * 128 + tid]; } while (0)
        PB_LOAD_RAW(c0);
        const int ti = wave >> 2, ej = wave & 3;
        bf16x8 cfr[8];
#define PB_LOAD_CFR(c_) do { const bf16* cp_ = CST + ((size_t)(bh * 32 + (c_)) * 128 + 32 * ej + r32) * 128 + 8 * hh; \
        _Pragma("unroll") for (int ks_ = 0; ks_ < 8; ++ks_) cfr[ks_] = *(const bf16x8*)(cp_ + 16 * ks_); } while (0)
        PB_LOAD_CFR(c0);
        for (int i8 = 0; i8 < 8; ++i8) {
        const int c = c0 + i8;
        const float lf = lfn, ig = ign, mprev = msn;
        const float bcum = wave_scan_add(lf, lane), uu = ig - bcum, pm = wave_scan_max(uu, lane), Mt = fmaxf(mprev, pm);
        if (wave == 0) { MR[lane] = Mt; AR[lane] = exp_f(mprev - Mt); EM[lane] = exp_f(-(bcum + Mt)); }
#pragma unroll
        for (int i = 0; i < 2; ++i) { const int s = 2 * s0 + i; u32x4 o;
            conv8_regs(rq[i], rq[i + 1], rq[i + 2], rq[i + 3], CW, CB, 0, dg, 1.0f, o); *(LAS u32x4*)(F.lds + PB_QS + (s * 136 + dg * 8) * 2) = o;
            conv8_regs(rk[i], rk[i + 1], rk[i + 2], rk[i + 3], CW, CB, 1, dg, 0.08838834764831845f, o); *(LAS u32x4*)(F.lds + PB_KS + (s * 136 + dg * 8) * 2) = o;
            *(LAS u32x4*)(F.lds + PB_VT + (s * 136 + dg * 8) * 2) = rv[i]; }
        const size_t hrow = (size_t)(b * SEQ + 64 * c + (tid >> 3));
        const u32x4 og0 = __builtin_nontemporal_load((const u32x4*)(proj + hrow * 4096 + 3072 + hcol)), og1 = __builtin_nontemporal_load((const u32x4*)(proj + hrow * 4096 + 3072 + hcol + 8));
        if (tid < 128) NV[tid] = nvn;
        if (i8 + 1 < 8) PB_LOAD_RAW(c + 1);
        LDS_BARRIER();
        f32x16 acc = {};
        {
#pragma unroll
          for (int ks = 0; ks < 8; ++ks) { const bf16x8 a = *(const LAS bf16x8*)(F.lds + PB_QS + ((32 * ti + r32) * 136 + 16 * ks + 8 * hh) * 2); acc = MFMA32(a, cfr[ks], acc); }
          if (i8 + 1 < 8) PB_LOAD_CFR(c + 1);
#pragma unroll
          for (int q = 0; q < 4; ++q) { const f32x4 av = *(const LAS f32x4*)(AR + 32 * ti + 8 * q + 4 * hh);
#pragma unroll
              for (int j = 0; j < 4; ++j) acc[4 * q + j] *= av[j]; } }
        if (wave < 3) { const int sti = (wave + 1) >> 1, sj = wave >> 1;
            f32x16 sa = {};
#pragma unroll
            for (int ks = 0; ks < 8; ++ks) { const bf16x8 a = *(const LAS bf16x8*)(F.lds + PB_QS + ((32 * sti + r32) * 136 + 16 * ks + 8 * hh) * 2); const bf16x8 bb = *(const LAS bf16x8*)(F.lds + PB_KS + ((32 * sj + r32) * 136 + 16 * ks + 8 * hh) * 2); sa = MFMA32(a, bb, sa); }
            const int s = 32 * sj + r32; const float us = __shfl(uu, s);
#pragma unroll
            for (int q = 0; q < 4; ++q) { const f32x4 mv = *(const LAS f32x4*)(MR + 32 * sti + 8 * q + 4 * hh);
#pragma unroll
                for (int j = 0; j < 4; ++j) { const int t = 32 * sti + 8 * q + 4 * hh + j; const float val = (s <= t) ? sa[4 * q + j] * exp_f(us - mv[j]) : 0.f;
                    *((LAS bf16*)(F.lds + PB_SQK) + t * 72 + s) = (bf16)(pk2(val, 0.f) & 0xffffu); } }
        } else if (wave == 3) {
#pragma unroll
            for (int r = 0; r < 16; ++r) { const int t = (r & 3) + 8 * (r >> 2) + 4 * hh; *((LAS bf16*)(F.lds + PB_SQK) + t * 72 + 32 + r32) = (bf16)0; } }
        LDS_BARRIER();
#pragma unroll
        for (int ks = 0; ks < 4; ++ks) { const bf16x8 a = *(const LAS bf16x8*)(F.lds + PB_SQK + ((32 * ti + r32) * 72 + 16 * ks + 8 * hh) * 2); const bf16x8 bb = tr_frag(F.lds + PB_VT + (16 * ks * 136 + 32 * ej) * 2, 272, lane); acc = MFMA32(a, bb, acc); }
#pragma unroll
        for (int r = 0; r < 16; ++r) { const int t = 32 * ti + (r & 3) + 8 * (r >> 2) + 4 * hh; *((LAS float*)(F.lds + PB_HF) + t * 132 + 32 * ej + r32) = acc[r]; }
        LDS_BARRIER();
        { const int t = tid >> 3, p = tid & 7; float dq = 0.f, ds = 0.f;
          { const u32x4 q0 = *(const LAS u32x4*)(F.lds + PB_QS + (t * 136 + 16 * p) * 2), q1 = *(const LAS u32x4*)(F.lds + PB_QS + (t * 136 + 16 * p + 8) * 2);
            const LAS f32x4* nv = (const LAS f32x4*)(NV + 16 * p); const f32x4 n0 = nv[0], n1 = nv[1], n2 = nv[2], n3 = nv[3];
            dq = (bflo(q0.x) * n0[0] + bfhi(q0.x) * n0[1]) + (bflo(q0.y) * n0[2] + bfhi(q0.y) * n0[3]) + (bflo(q0.z) * n1[0] + bfhi(q0.z) * n1[1]) + (bflo(q0.w) * n1[2] + bfhi(q0.w) * n1[3])
               + (bflo(q1.x) * n2[0] + bfhi(q1.x) * n2[1]) + (bflo(q1.y) * n2[2] + bfhi(q1.y) * n2[3]) + (bflo(q1.z) * n3[0] + bfhi(q1.z) * n3[1]) + (bflo(q1.w) * n3[2] + bfhi(q1.w) * n3[3]);
            const u32x4 sq = *(const LAS u32x4*)(F.lds + PB_SQK + (t * 72 + 8 * p) * 2);
            ds = ((bflo(sq.x) + bfhi(sq.x)) + (bflo(sq.y) + bfhi(sq.y))) + ((bflo(sq.z) + bfhi(sq.z)) + (bflo(sq.w) + bfhi(sq.w))); }
          float den = AR[t] * dq + ds; den += __shfl_xor(den, 1); den += __shfl_xor(den, 2); den += __shfl_xor(den, 4);
          const float inv = __builtin_amdgcn_rcpf(fmaxf(fabsf(den), EM[t]));
          const LAS f32x4* hp = (const LAS f32x4*)((LAS float*)(F.lds + PB_HF) + t * 132 + 16 * p); float x[16]; float ss = 0.f;
#pragma unroll
          for (int i = 0; i < 4; ++i) { const f32x4 v = hp[i]; x[4 * i] = v[0] * inv; x[4 * i + 1] = v[1] * inv; x[4 * i + 2] = v[2] * inv; x[4 * i + 3] = v[3] * inv; }
#pragma unroll
          for (int i = 0; i < 16; ++i) ss += x[i] * x[i];
          ss += __shfl_xor(ss, 1); ss += __shfl_xor(ss, 2); ss += __shfl_xor(ss, 4);
          const float rn = __builtin_amdgcn_rsqf(ss * (1.0f / 128.0f) + EPS);
          const size_t row = hrow; const int col = hcol;
          const unsigned ow[8] = {og0.x, og0.y, og0.z, og0.w, og1.x, og1.y, og1.z, og1.w};
          const LAS f32x4* gq = (const LAS f32x4*)((LAS float*)(F.lds + PB_NG) + 16 * p); const f32x4 ng0 = gq[0], ng1 = gq[1], ng2 = gq[2], ng3 = gq[3];
          const float gn[16] = {ng0[0], ng0[1], ng0[2], ng0[3], ng1[0], ng1[1], ng1[2], ng1[3], ng2[0], ng2[1], ng2[2], ng2[3], ng3[0], ng3[1], ng3[2], ng3[3]};
          unsigned res[8];
#pragma unroll
          for (int i = 0; i < 8; ++i) res[i] = pk2(x[2 * i] * rn * gn[2 * i] * sigmoid_f(bflo(ow[i])), x[2 * i + 1] * rn * gn[2 * i + 1] * sigmoid_f(bfhi(ow[i])));
          pg8::st16(Y + row * 1024 + col, (u32x4){res[0], res[1], res[2], res[3]}); pg8::st16(Y + row * 1024 + col + 8, (u32x4){res[4], res[5], res[6], res[7]}); }
        LDS_BARRIER();
        }
#undef PB_LOAD_RAW
    }
}

constexpr int SG_VT = 0, SG_WS = 256 * 136 * 2, SG_ST = SG_WS + 128 * 136 * 2;
__device__ __forceinline__ void sgu_phase(Frame& F, const bf16* Z, const float* lnp, const float* lg, const float* lb, const bf16* WM, const float* bs, bf16* OUT) {
    const int tid = F.tid, lane = F.lane, wave = F.wave, r32 = lane & 31, hh = lane >> 5;
    LAS float* ST = (LAS float*)(F.lds + SG_ST);
    for (int u = F.vcu; u < 1024; u += F.G) {
        const int span = u >> 3, g = u & 7; const size_t row0 = (size_t)span * 128;
        { const int r = tid >> 2, p = tid & 3; const f32x4* pp = (const f32x4*)(lnp + ((row0 + r) * 32 + 8 * p) * 2); float s1 = 0.f, s2 = 0.f;
#pragma unroll
          for (int i = 0; i < 4; ++i) { const f32x4 v = pp[i]; s1 += v[0] + v[2]; s2 += v[1] + v[3]; }
          s1 += __shfl_xor(s1, 1); s1 += __shfl_xor(s1, 2); s2 += __shfl_xor(s2, 1); s2 += __shfl_xor(s2, 2);
          const float mu = s1 * (1.0f / 2048.0f), var = fmaxf(s2 * (1.0f / 2048.0f) - mu * mu, 0.f);
          if (p == 0) { ST[2 * r] = mu; ST[2 * r + 1] = 1.0f / sqrtf(var + EPS); } }
#pragma unroll
        for (int i = 0; i < 4; ++i) { const int item = tid + 512 * i, t = item >> 4, sg = item & 15; *(LAS u32x4*)(F.lds + SG_WS + (t * 136 + sg * 8) * 2) = *(const u32x4*)(WM + ((size_t)g * 128 + t) * 128 + sg * 8); }
        __syncthreads();
#pragma unroll
        for (int i = 0; i < 8; ++i) { const int item = tid + 512 * i, s = item >> 5, cg8 = item & 31; const int col = g * 256 + cg8 * 8;
            const u32x4 x = *(const u32x4*)(Z + (row0 + s) * 4096 + 2048 + col); const float mu = ST[2 * s], rs = ST[2 * s + 1];
            const f32x4 g0 = *(const f32x4*)(lg + col), g1 = *(const f32x4*)(lg + col + 4), b0 = *(const f32x4*)(lb + col), b1 = *(const f32x4*)(lb + col + 4);
            LAS bf16* vt = (LAS bf16*)(F.lds + SG_VT) + (cg8 * 8) * 136 + s;
            vt[0 * 136] = (bf16)(pk2((bflo(x.x) - mu) * rs * g0[0] + b0[0], 0.f) & 0xffffu); vt[1 * 136] = (bf16)(pk2((bfhi(x.x) - mu) * rs * g0[1] + b0[1], 0.f) & 0xffffu);
            vt[2 * 136] = (bf16)(pk2((bflo(x.y) - mu) * rs * g0[2] + b0[2], 0.f) & 0xffffu); vt[3 * 136] = (bf16)(pk2((bfhi(x.y) - mu) * rs * g0[3] + b0[3], 0.f) & 0xffffu);
            vt[4 * 136] = (bf16)(pk2((bflo(x.z) - mu) * rs * g1[0] + b1[0], 0.f) & 0xffffu); vt[5 * 136] = (bf16)(pk2((bfhi(x.z) - mu) * rs * g1[1] + b1[1], 0.f) & 0xffffu);
            vt[6 * 136] = (bf16)(pk2((bflo(x.w) - mu) * rs * g1[2] + b1[2], 0.f) & 0xffffu); vt[7 * 136] = (bf16)(pk2((bfhi(x.w) - mu) * rs * g1[3] + b1[3], 0.f) & 0xffffu); }
        __syncthreads();
        f32x16 acc[4] = {};
#pragma unroll
        for (int ks = 0; ks < 8; ++ks) { const bf16x8 bb = *(const LAS bf16x8*)(F.lds + SG_VT + ((32 * wave + r32) * 136 + 16 * ks + 8 * hh) * 2);
#pragma unroll
            for (int ti = 0; ti < 4; ++ti) { const bf16x8 a = *(const LAS bf16x8*)(F.lds + SG_WS + ((32 * ti + r32) * 136 + 16 * ks + 8 * hh) * 2); acc[ti] = MFMA32(a, bb, acc[ti]); } }
        const int col = g * 256 + 32 * wave + r32;
#pragma unroll
        for (int ti = 0; ti < 4; ++ti)
#pragma unroll
            for (int r = 0; r < 16; ++r) { const int t = 32 * ti + (r & 3) + 8 * (r >> 2) + 4 * hh; const float uv = bf2f(Z[(row0 + t) * 4096 + col]);
                OUT[(row0 + t) * 2048 + col] = (bf16)(pk2(uv * (acc[ti][r] + bs[g * 128 + t]), 0.f) & 0xffffu); }
        __syncthreads();
    }
}

constexpr int SG2_VI = 0, SG2_WS = 67584, SG2_ST = SG2_WS + 34816, SG2_BS = SG2_ST + 1024;
__device__ __forceinline__ void sgu_phase2(Frame& F, const bf16* Z, const float* lnp, const float* lg, const float* lb, const bf16* WM, const float* bs, bf16* OUT) {
    const int tid = F.tid, lane = F.lane, wave = F.wave, r32 = lane & 31, hh = lane >> 5;
    LAS float* ST = (LAS float*)(F.lds + SG2_ST); LAS float* BS = (LAS float*)(F.lds + SG2_BS); LAS float* SF = (LAS float*)(F.lds + SG2_VI);
    if ((F.G & 7) == 0) {
        const int g = F.vcu & 7;
        u32x4 wmv[4];
        float bsv = 0.f; if (tid < 128) bsv = bs[g * 128 + tid];
#pragma unroll
        for (int i = 0; i < 4; ++i) { const int item = tid + 512 * i, t = item >> 4, sg = item & 15; wmv[i] = *(const u32x4*)(WM + ((size_t)g * 128 + t) * 128 + sg * 8); }
#pragma unroll
        for (int i = 0; i < 4; ++i) { const int item = tid + 512 * i, t = item >> 4, sg = item & 15; *(LAS u32x4*)(F.lds + SG2_WS + (t * 136 + sg * 8) * 2) = wmv[i]; }
        if (tid < 128) BS[tid] = bsv;
    }
    for (int u = F.vcu; u < 1024; u += F.G) {
        const int span = u >> 3, g = u & 7; const size_t row0 = (size_t)span * 128;
        const int cg8 = tid & 31, colv = g * 256 + cg8 * 8;
        u32x4 xv[8];
#pragma unroll
        for (int i = 0; i < 8; ++i) xv[i] = __builtin_nontemporal_load((const u32x4*)(Z + (row0 + (tid >> 5) + 16 * i) * 4096 + 2048 + colv));

        const f32x4 g0 = *(const f32x4*)(lg + colv), g1 = *(const f32x4*)(lg + colv + 4), b0 = *(const f32x4*)(lb + colv), b1 = *(const f32x4*)(lb + colv + 4);
        { const int r = tid >> 2, p = tid & 3; const f32x4* pp = (const f32x4*)(lnp + ((row0 + r) * 32 + 8 * p) * 2); float s1 = 0.f, s2 = 0.f;
#pragma unroll
          for (int i = 0; i < 4; ++i) { const f32x4 v = pp[i]; s1 += v[0] + v[2]; s2 += v[1] + v[3]; }
          s1 += __shfl_xor(s1, 1); s1 += __shfl_xor(s1, 2); s2 += __shfl_xor(s2, 1); s2 += __shfl_xor(s2, 2);
          const float mu = s1 * (1.0f / 2048.0f), var = fmaxf(s2 * (1.0f / 2048.0f) - mu * mu, 0.f);
          if (p == 0) { ST[2 * r] = mu; ST[2 * r + 1] = 1.0f / sqrtf(var + EPS); } }

        LDS_BARRIER();
#pragma unroll
        for (int i = 0; i < 8; ++i) { const int s = (tid >> 5) + 16 * i; const u32x4 x = xv[i]; const float mu = ST[2 * s], rs = ST[2 * s + 1];
            u32x4 o; o.x = pk2((bflo(x.x) - mu) * rs * g0[0] + b0[0], (bfhi(x.x) - mu) * rs * g0[1] + b0[1]); o.y = pk2((bflo(x.y) - mu) * rs * g0[2] + b0[2], (bfhi(x.y) - mu) * rs * g0[3] + b0[3]);
            o.z = pk2((bflo(x.z) - mu) * rs * g1[0] + b1[0], (bfhi(x.z) - mu) * rs * g1[1] + b1[1]); o.w = pk2((bflo(x.w) - mu) * rs * g1[2] + b1[2], (bfhi(x.w) - mu) * rs * g1[3] + b1[3]);
            *(LAS u32x4*)(F.lds + SG2_VI + (s * 264 + cg8 * 8) * 2) = o; }
        u32x4 uv[2][4];
#pragma unroll
        for (int p = 0; p < 2; ++p)
#pragma unroll
            for (int i = 0; i < 4; ++i) { const int idx = tid + 512 * i, tl = idx >> 5, c8 = idx & 31; uv[p][i] = __builtin_nontemporal_load((const u32x4*)(Z + (row0 + 64 * p + tl) * 4096 + g * 256 + c8 * 8)); }
        LDS_BARRIER();
        f32x16 acc[4] = {};
#pragma unroll
        for (int ks = 0; ks < 8; ++ks) { const bf16x8 bb = tr_frag(F.lds + SG2_VI + (16 * ks * 264 + 32 * wave) * 2, 528, lane);
#pragma unroll
            for (int ti = 0; ti < 4; ++ti) { const bf16x8 a = *(const LAS bf16x8*)(F.lds + SG2_WS + ((32 * ti + r32) * 136 + 16 * ks + 8 * hh) * 2); acc[ti] = MFMA32(a, bb, acc[ti]); } }
        LDS_BARRIER();
#pragma unroll
        for (int p = 0; p < 2; ++p) {
#pragma unroll
            for (int tt = 0; tt < 2; ++tt)
#pragma unroll
                for (int r = 0; r < 16; ++r) { const int tl = 32 * tt + (r & 3) + 8 * (r >> 2) + 4 * hh; SF[tl * 260 + 32 * wave + r32] = acc[2 * p + tt][r] + BS[64 * p + tl]; }
            LDS_BARRIER();
#pragma unroll
            for (int i = 0; i < 4; ++i) { const int idx = tid + 512 * i, tl = idx >> 5, c8 = idx & 31; const size_t row = row0 + 64 * p + tl; const int col = g * 256 + c8 * 8;
                const f32x4 f0 = *(const LAS f32x4*)(SF + tl * 260 + c8 * 8), f1 = *(const LAS f32x4*)(SF + tl * 260 + c8 * 8 + 4);
                const u32x4 x = uv[p][i];
                u32x4 o; o.x = pk2(bflo(x.x) * f0[0], bfhi(x.x) * f0[1]); o.y = pk2(bflo(x.y) * f0[2], bfhi(x.y) * f0[3]); o.z = pk2(bflo(x.z) * f1[0], bfhi(x.z) * f1[1]); o.w = pk2(bflo(x.w) * f1[2], bfhi(x.w) * f1[3]);
                pg8::st16(OUT + row * 2048 + col, o); }
            LDS_BARRIER();
        }
    }
}
__device__ __forceinline__ void final_norm(Frame& F, const float* ssq, const float* fg) {
    const int gw = F.vcu * NWAVES + F.wave, NGW = F.G * NWAVES, lane = F.lane; const bf16* XB = (const bf16*)(F.ws + WS_XB);
    const f32x4* gp = (const f32x4*)fg + lane; f32x4 gg[4];
#pragma unroll
    for (int j = 0; j < 4; ++j) gg[j] = gp[64 * j];
    for (int mb = gw; mb < M; mb += 4 * NGW) { unsigned long long w[4][4]; float sq[4];
#pragma unroll
        for (int k = 0; k < 4; ++k) { const int m = mb + k * NGW; sq[k] = 0.f;
            if (m < M) { sq[k] = (lane < 16) ? ssq[(size_t)m * 16 + lane] : 0.f;
#pragma unroll
                for (int j = 0; j < 4; ++j) w[k][j] = __builtin_nontemporal_load((const unsigned long long*)(XB + (size_t)m * D) + lane + 64 * j); } }
        __builtin_amdgcn_sched_barrier(0);
#pragma unroll
        for (int k = 0; k < 4; ++k) { const int m = mb + k * NGW;
            if (m < M) { const float s = wave_sum(sq[k]); const float r = 1.0f / sqrtf(s * (1.0f / 1024.0f) + EPS);
                f32x4* xo = (f32x4*)(F.out + (size_t)m * D) + lane;
#pragma unroll
                for (int j = 0; j < 4; ++j) { const unsigned w0 = (unsigned)w[k][j], w1 = (unsigned)(w[k][j] >> 32);
                    __builtin_nontemporal_store((f32x4){bflo(w0) * r * gg[j][0], bfhi(w0) * r * gg[j][1], bflo(w1) * r * gg[j][2], bfhi(w1) * r * gg[j][3]}, xo + 64 * j); } } } }
}

#ifndef MK_BPRE
#define MK_BPRE 1
#endif
#ifndef MK_FUSE_FINAL
#define MK_FUSE_FINAL 1
#endif
struct Args { const float* in[22]; float* out; unsigned char* ws; int ph_lo, ph_hi; };
constexpr int NPHASE = 26;
__global__ void __launch_bounds__(NWAVES * 64, 2) mk_fwd(Args args) {
    extern __shared__ __attribute__((aligned(16))) unsigned char lds_raw[];
    __builtin_assume(threadIdx.y == 0); __builtin_assume(threadIdx.z == 0);
    const int wv0 = __builtin_amdgcn_readfirstlane((int)threadIdx.x >> 6);
    Frame F;
    F.lds = (ldsp)lds_raw;
    F.inp = args.in;
    F.out = args.out; F.ws = args.ws;
    cg::grid_group grid = cg::this_grid();
    { const int t0 = mk_ltid(wv0); for (int u = t0; u < 128; u += NWAVES * 64) ((LAS unsigned*)(F.lds + LDSCTL_OFF))[u] = 0u; __syncthreads();
    }
    XcdBarrier bar = xcd_barrier_post((unsigned*)args.ws + CW_BAR, (volatile LAS unsigned*)(F.lds + LDSCTL_OFF) + 8, mk_ltid(wv0));
#ifndef MK_REP_N
#define MK_REP_N 0
#endif
#ifndef MK_REP_MATCH
#define MK_REP_MATCH(ph, slot, kind) false
#endif
#ifndef MK_EXTRA_SYNCS
#define MK_EXTRA_SYNCS 0
#endif
    int rep = 0; bool bpre_next = false;
    for (int ph = args.ph_lo; ph < args.ph_hi; ) {
        bool did = true; const bool bpre = bpre_next;
        F.tid = mk_ltid(wv0); F.lane = F.tid & 63; F.wave = __builtin_amdgcn_readfirstlane(F.tid >> 6);
        int bx = blockIdx.x, gd = gridDim.x; asm volatile("" : "+s"(bx), "+s"(gd)); F.G = gd; F.vcu = (gd % 8 == 0) ? (bx % 8) * (gd / 8) + bx / 8 : bx;
        unsigned long long wsi = (unsigned long long)args.ws; asm volatile("" : "+s"(wsi)); unsigned char* ws = (unsigned char*)(__attribute__((address_space(1))) unsigned char*)wsi; F.ws = ws;
        float* SSQ = (float*)(ws + WS_SSQ); bf16* XB = (bf16*)(ws + WS_XB); bf16* PROJ = (bf16*)(ws + WS_PROJ);
        if (ph == 0) {
#ifndef DIS_P0
 p0_prologue(F);
#endif
 }
        else if (ph == NPHASE - 1) {
#ifndef DIS_FIN
 if (!(MK_FUSE_FINAL && F.G == 256)) final_norm(F, SSQ, F.in_(3)); else did = false;
#endif
 }
        else {
            const int layer = (ph - 1) / 6, slot = (ph - 1) % 6, kind = layer % 3, j = layer / 3;
            if (slot == 0) {
                if (kind == 2) {
                    pg8::Gemm g{XB, (const bf16*)(ws + WS_W + W_CIN), M, 4096, D}; pg8::StaticOrder S; S.init(M, 4096, F.G, bx);
                    RstdPre pre{&S, SSQ, (LAS float*)(F.lds + RS_OFF)}; pg8::EpiGeluLn E{PROJ, (const LAS float*)(F.lds + RS_OFF), (float*)(ws + WS_LNP)};
#ifndef DIS_G3
                    pg8::gemm_phase<pg8::EpiGeluLn, pg8::StaticOrder, PG8_ALIGN, PG8_SP2, RstdPre>(F.lds, g, S, E, wv0, pre, bpre);
#endif
                } else {
                    const int N = (kind == 0) ? 3072 : 4096;
                    pg8::Gemm g{XB, (const bf16*)(ws + WS_W + ((kind == 0) ? W_AIN + j * SZ_AIN : W_BIN)), M, N, D}; pg8::StaticOrder S; S.init(M, N, F.G, bx);
                    RstdPre pre{&S, SSQ, (LAS float*)(F.lds + RS_OFF)}; pg8::EpiScaleBf16 E{PROJ, (kind == 0) ? 1024 : 4096, (const LAS float*)(F.lds + RS_OFF), (kind == 0) ? 1024 : 0, (size_t)16 * MiB, attn_body::C2};
#ifndef DIS_G1
                    pg8::gemm_phase<pg8::EpiScaleBf16, pg8::StaticOrder, PG8_ALIGN, PG8_SP2, RstdPre>(F.lds, g, S, E, wv0, pre, bpre);
#endif
#ifndef DIS_GATE
#ifdef MK_GATE_LASTREP
                    if (rep == MK_REP_N || !(MK_REP_MATCH(ph, slot, kind)))
#endif
                    { if (kind == 0) gate_items<0>(F, XB, (const bf16*)(ws + WS_WG) + (size_t)j * 16384, SSQ, F.in_(5) + j * 16, nullptr, (float*)(ws + WS_LOGF), nullptr);
                    else gate_items<1>(F, XB, (const bf16*)(ws + WS_WG) + (size_t)2 * 16384, SSQ, F.in_(10), F.in_(11), (float*)(ws + WS_IG), (float*)(ws + WS_LF)); }
#endif
                }
            } else if (slot == 1) {
                if (kind == 0) {
                    const attn_body::AttnTensors AT{(const attn_body::bf16*)PROJ, (const attn_body::bf16*)(ws + WS_PROJ + 32 * MiB), (const attn_body::bf16*)(ws + WS_PROJ + 64 * MiB), (attn_body::bf16*)PROJ, (const float*)(ws + WS_LOGF)};
                    const attn_body::StaticOrder S((int)F.G, bx);
#ifdef MK_ATTN_TWICE
                    { const attn_body::AttnTensors AT0{AT.Q, AT.K, AT.V, (attn_body::bf16*)(ws + WS_S1), AT.LOGF}; attn_body::attn_phase<attn_body::StaticOrder>((char*)lds_raw, AT0, S, wv0); xcd_barrier(bar, F.tid); }
#endif
#ifndef DIS_ATTN
                    attn_body::attn_phase<attn_body::StaticOrder>((char*)lds_raw, AT, S, wv0);
#endif
                } else if (kind == 1) {
#ifndef DIS_PA
                    mlstm_pass_a(F, PROJ, (const float*)(ws + WS_IG), (const float*)(ws + WS_LF), F.in_(8), F.in_(9), (bf16*)F.out, (float*)(ws + WS_NS), (float*)(ws + WS_MS));
#endif
                } else {
#ifndef DIS_SGU
                    sgu_phase2(F, PROJ, (const float*)(ws + WS_LNP), F.in_(15), F.in_(16), (const bf16*)(ws + WS_WM), F.in_(18), (bf16*)(ws + WS_S1));
#endif
                }
            } else if (slot == 2) {
#ifndef DIS_PB
                if (kind == 1) mlstm_pass_b(F, PROJ, (const float*)(ws + WS_IG), (const float*)(ws + WS_LF), F.in_(8), F.in_(9), (const bf16*)F.out, (const float*)(ws + WS_NS), (const float*)(ws + WS_MS), F.in_(12), (bf16*)(ws + WS_S2));
                else
#endif
                did = false;
            } else if (slot == 3 || slot == 5) {
                const bf16* A; const bf16* Bt; int K;
                if (slot == 5) { A = PROJ; Bt = (const bf16*)(ws + WS_W + W_DN + layer * SZ_DN); K = DFF; }
                else if (kind == 0) { A = PROJ; Bt = (const bf16*)(ws + WS_W + W_AOUT + j * SZ_AOUT); K = D; }
                else if (kind == 1) { A = (const bf16*)(ws + WS_S2); Bt = (const bf16*)(ws + WS_W + W_BOUT); K = D; }
                else { A = (const bf16*)(ws + WS_S1); Bt = (const bf16*)(ws + WS_W + W_COUT); K = 2048; }
                pg8::Gemm g{A, Bt, M, D, K}; pg8::StaticOrder S; S.init(M, D, F.G, bx);
#ifdef MK_RES_TWICE
                if (MK_RES_TWICE(slot, kind)) { bf16* scr = (slot == 5) ? (bf16*)(ws + WS_S1) : (kind == 0) ? (bf16*)(ws + WS_PROJ + 64 * MiB) : PROJ;
                    pg8::EpiResidualB E0{XB, scr, (float*)(ws + WS_LNP), 0, nullptr, nullptr, nullptr, nullptr}; pg8::gemm_phase<pg8::EpiResidualB, pg8::StaticOrder, true, PG8_SP2>(F.lds, g, S, E0, wv0); xcd_barrier(bar, F.tid); }
#endif
                const int fin = (MK_FUSE_FINAL && slot == 5 && layer == 3 && F.G == 256) ? 1 : 0;
                pg8::EpiResidualB E{XB, XB, SSQ, fin, F.out, F.in_(3), (unsigned*)ws + CW_PANEL, (unsigned*)ws + CW_BAR + XB_TMO};
#ifndef DIS_G4
                pg8::gemm_phase<pg8::EpiResidualB, pg8::StaticOrder, true, PG8_SP2>(F.lds, g, S, E, wv0, pg8::NoPre(), bpre);
#endif
            } else {
                pg8::Gemm g{XB, (const bf16*)(ws + WS_W + W_GU + layer * SZ_GU), M, 2 * DFF, D}; pg8::StaticOrder S; S.init(M, 2 * DFF, F.G, bx);
                RstdPre pre{&S, SSQ, (LAS float*)(F.lds + RS_OFF)}; pg8::EpiSwiGLU E{PROJ, (const LAS float*)(F.lds + RS_OFF)};
#ifndef DIS_G2
                pg8::gemm_phase<pg8::EpiSwiGLU, pg8::StaticOrder, PG8_ALIGN, PG8_SP2, RstdPre>(F.lds, g, S, E, wv0, pre, bpre);
                if (F.G == 256 && layer < 3 && bx >= 128) p0_convert(F, layer + 1, false, (bx - 128) * NWAVES + F.wave, 128 * NWAVES, P0_FFN + ((layer == 0) ? P0_I_BIN + P0_I_SQ : (layer == 1) ? P0_I_BIN + P0_I_COUT : P0_I_AIN + P0_I_SQ));
#endif
            }
        }
        if (did && ph + 1 < args.ph_hi && !(MK_FUSE_FINAL && F.G == 256 && ph == NPHASE - 2)) { const int ns = (MK_EXTRA_SYNCS > 0 && ph == 1) ? 1 + MK_EXTRA_SYNCS : 1;
            if (args.ph_hi < 0) grid.sync();
            BPre bp{nullptr, 0, 0, F.lds}; bpre_next = false;
#if MK_BPRE
            if (F.G == 256 && ph >= 1 && MK_REP_N == 0) {
                int q = ph + 1; { const int sl = (q - 1) % 6, kd = ((q - 1) / 6) % 3; if (sl == 2 && kd != 1) ++q; }
                if (q < NPHASE - 1) { const int ly = (q - 1) / 6, sl = (q - 1) % 6, kd = ly % 3, jj = ly / 3; size_t wo = 0; int N = 0, K = D; bool gm = true;
                    if (sl == 0) { wo = (kd == 0) ? W_AIN + jj * SZ_AIN : (kd == 1) ? W_BIN : W_CIN; N = (kd == 0) ? 3072 : 4096; }
                    else if (sl == 3) { wo = (kd == 0) ? W_AOUT + jj * SZ_AOUT : (kd == 1) ? W_BOUT : W_COUT; N = D; K = (kd == 2) ? 2048 : D; }
                    else if (sl == 4) { wo = W_GU + ly * SZ_GU; N = 2 * DFF; }
                    else if (sl == 5) { wo = W_DN + ly * SZ_DN; N = D; K = DFF; }
                    else gm = false;
                    if (gm) { pg8::StaticOrder S2; S2.init(M, N, F.G, bx); pg8::Unit u2; if (S2.next(0, u2)) { bp.Bt = (const bf16*)(ws + WS_W + wo); bp.K = K; bp.pn = u2.pn; bpre_next = true; } } } }
#endif
            for (int k = 0; k < ns; ++k) xcd_barrier(bar, F.tid, (k == 0) ? bp : BPre{nullptr, 0, 0, F.lds}); }
        if (MK_REP_N > 0 && ph > 0 && ph < NPHASE - 1 && MK_REP_MATCH(ph, ((ph - 1) % 6), (((ph - 1) / 6) % 3)) && rep < MK_REP_N) ++rep; else if (MK_REP_N > 0 && ph == 0 && MK_REP_MATCH(0, -1, -1) && rep < MK_REP_N) ++rep; else { rep = 0; ++ph; }
    }
}

#ifndef MK_PER_PHASE
#define MK_PER_PHASE 0
#endif
extern "C" void kernel_launch(void* const* d_in, const int* in_sizes, int n_in, void* d_out, int out_size, void* d_ws, size_t ws_size, hipStream_t stream) {
    static int grid = 0;
    if (grid == 0) {
        if (n_in != 22 || out_size != M * D || ws_size < WS_END) { fprintf(stderr, "kernel_launch: unexpected shapes (n_in %d out %d ws %zu)\n", n_in, out_size, ws_size); grid = -1; return; }
        int dev = 0, cus = 0, per_cu = 0;
        (void)hipGetDevice(&dev); (void)hipDeviceGetAttribute(&cus, hipDeviceAttributeMultiprocessorCount, dev);
        if (hipFuncSetAttribute((const void*)mk_fwd, hipFuncAttributeMaxDynamicSharedMemorySize, LDS_BYTES) != hipSuccess) { fprintf(stderr, "kernel_launch: hipFuncSetAttribute failed\n"); grid = -1; return; }
        if (hipOccupancyMaxActiveBlocksPerMultiprocessor(&per_cu, (const void*)mk_fwd, NWAVES * 64, LDS_BYTES) != hipSuccess || per_cu < 1) { fprintf(stderr, "kernel_launch: occupancy query says %d\n", per_cu); per_cu = 1; }
        (void)hipGetLastError();
        grid = cus - (cus % 8);
        fprintf(stderr, "kernel_launch: grid %d (per_cu %d)\n", grid, per_cu);
    }
    if (grid < 0) return;
    if (hipMemsetAsync(d_ws, 0, CTL_ZERO_BYTES, stream) != hipSuccess) { fprintf(stderr, "kernel_launch: memset failed\n"); return; }
    Args a{};
    for (int i = 0; i < 22; ++i) a.in[i] = (const float*)d_in[i];
    a.out = (float*)d_out; a.ws = (unsigned char*)d_ws;
#if MK_PER_PHASE
    for (int ph = 0; ph < NPHASE; ++ph) { a.ph_lo = ph; a.ph_hi = ph + 1; void* kargs[] = {&a};
        hipError_t e = hipLaunchCooperativeKernel((const void*)mk_fwd, dim3(grid), dim3(NWAVES * 64), kargs, LDS_BYTES, stream);
        if (e != hipSuccess) { fprintf(stderr, "launch failed: %s\n", hipGetErrorString(e)); break; } }
#else
    a.ph_lo = 0; a.ph_hi = NPHASE; void* kargs[] = {&a};
    hipError_t e = hipLaunchCooperativeKernel((const void*)mk_fwd, dim3(grid), dim3(NWAVES * 64), kargs, LDS_BYTES, stream);
    if (e != hipSuccess) fprintf(stderr, "cooperative launch failed: %s (grid %d)\n", hipGetErrorString(e), grid);
#endif
}
```
